# Optimizing an MI355X kernel written in HIP

```python
import math
import jax, jax.numpy as jnp
from jax import lax
import numpy as np

D_MODEL = 2048
BATCH = 4
SEQ = 2048
DEPTH = 1

POOL_WIDTH = D_MODEL // 2
POOL_WINDOWS = (2, 4, 8, 16)
POOL_GROUPS = len(POOL_WINDOWS)
POOL_GROUP_DIM = POOL_WIDTH // POOL_GROUPS
SB_HEAD_DIM = 128
SB_HEADS = (D_MODEL // 2) // SB_HEAD_DIM
SB_WIDTH = SB_HEADS * SB_HEAD_DIM
N_BRANCHES = 2
IN_WIDTH = POOL_WIDTH + 3 * SB_WIDTH + N_BRANCHES * D_MODEL
D_FF = 4 * D_MODEL
Q_BLOCK = 128
N_MOD = 6
EPS = 1e-6

kernel_name = "hybrid_pool_stickbreak_gated_block"


def rms_norm(x, w):
    xf = x.astype(jnp.float32)
    y = xf * lax.rsqrt(jnp.mean(jnp.square(xf), axis=-1, keepdims=True) + EPS)
    return (y * w.astype(jnp.float32)).astype(x.dtype)


def multiscale_pool(u, w_pool, pool_scale):
    B, S, _ = u.shape
    uf = u.astype(jnp.float32).reshape(B, S, POOL_GROUPS, POOL_GROUP_DIM)
    cs = jnp.cumsum(uf, axis=1)
    pos = jnp.arange(S, dtype=jnp.int32)
    outs = []
    for g, w in enumerate(POOL_WINDOWS):
        csg = cs[:, :, g]
        lag = jnp.pad(csg, ((0, 0), (w, 0), (0, 0)))[:, :S]
        count = jnp.minimum(pos + 1, w).astype(jnp.float32)[None, :, None]
        outs.append((csg - lag) / count - uf[:, :, g])
    pooled = jnp.stack(outs, axis=2)
    mixed = jnp.einsum('bsgc,gce->bsge', pooled, w_pool.astype(jnp.float32))
    y = mixed.reshape(B, S, POOL_WIDTH) * pool_scale.astype(jnp.float32)
    return y.astype(u.dtype)


def stick_breaking_attention(q, k, v):
    B, S, H, Dh = q.shape
    nb = S // Q_BLOCK
    scale = 1.0 / math.sqrt(Dh)
    kh = k.transpose(0, 2, 1, 3)
    vh = v.transpose(0, 2, 1, 3)
    qb = q.transpose(0, 2, 1, 3).reshape(B, H, nb, Q_BLOCK, Dh).transpose(2, 0, 1, 3, 4)
    starts = jnp.arange(nb, dtype=jnp.int32) * Q_BLOCK
    key_pos = jnp.arange(S, dtype=jnp.int32)

    def block(args):
        q_blk, t0 = args
        z = jnp.einsum('bhqd,bhkd->bhqk', q_blk, kh).astype(jnp.float32) * scale
        q_pos = t0 + jnp.arange(Q_BLOCK, dtype=jnp.int32)
        mask = key_pos[None, :] < q_pos[:, None]
        log_beta = jax.nn.log_sigmoid(z)
        log_1m_beta = log_beta - z
        l = jnp.where(mask, log_1m_beta, 0.0)
        suffix = lax.cumsum(l, axis=3, reverse=True) - l
        a = jnp.where(mask, jnp.exp(log_beta + suffix), 0.0)
        return jnp.einsum('bhqk,bhkd->bhqd', a.astype(vh.dtype), vh)

    out = lax.map(block, (qb, starts))
    return out.transpose(1, 0, 3, 2, 4).reshape(B, S, H * Dh)


def setup_inputs(seed: int = 0) -> dict:
    key = jax.random.key(seed)
    ks = jax.random.split(key, 20)
    f32 = jnp.float32
    L = DEPTH

    def nrm(k, shape, fan_in, gain=1.0):
        return jax.random.normal(k, shape, f32) * (gain * fan_in ** -0.5)

    return {
        "x": jax.random.normal(ks[0], (BATCH, SEQ, D_MODEL), f32),
        "c": jax.random.normal(ks[1], (BATCH, D_MODEL), f32),
        "w_ada": nrm(ks[2], (L, D_MODEL, N_MOD * D_MODEL), D_MODEL, 0.5),
        "b_ada": 0.02 * jax.random.normal(ks[3], (L, N_MOD * D_MODEL), f32),
        "norm1_w": 1.0 + 0.05 * jax.random.normal(ks[4], (L, D_MODEL), f32),
        "w_in": nrm(ks[5], (L, D_MODEL, IN_WIDTH), D_MODEL),
        "q_norm_w": 1.0 + 0.05 * jax.random.normal(ks[6], (L, SB_HEAD_DIM), f32),
        "k_norm_w": 1.0 + 0.05 * jax.random.normal(ks[7], (L, SB_HEAD_DIM), f32),
        "w_pool": nrm(ks[8], (L, POOL_GROUPS, POOL_GROUP_DIM, POOL_GROUP_DIM), POOL_GROUP_DIM),
        "pool_scale": 1.0 + 0.1 * jax.random.normal(ks[9], (L, POOL_WIDTH), f32),
        "w_a_up": nrm(ks[10], (L, POOL_WIDTH, D_MODEL), POOL_WIDTH),
        "w_b_up": nrm(ks[11], (L, SB_WIDTH, D_MODEL), SB_WIDTH),
        "w_o": nrm(ks[12], (L, D_MODEL, D_MODEL), D_MODEL),
        "norm2_w": 1.0 + 0.05 * jax.random.normal(ks[13], (L, D_MODEL), f32),
        "w_ff1": nrm(ks[14], (L, D_MODEL, D_FF), D_MODEL),
        "w_ff2": nrm(ks[15], (L, D_FF, D_MODEL), D_FF),
    }


def reference(x, c, w_ada, b_ada, norm1_w, w_in, q_norm_w, k_norm_w, w_pool, pool_scale,
              w_a_up, w_b_up, w_o, norm2_w, w_ff1, w_ff2):
    B, S, D = x.shape
    split_at = [POOL_WIDTH, POOL_WIDTH + SB_WIDTH, POOL_WIDTH + 2 * SB_WIDTH,
                POOL_WIDTH + 3 * SB_WIDTH, POOL_WIDTH + 3 * SB_WIDTH + D_MODEL]
    for l in range(DEPTH):
        mod = jax.nn.silu(c) @ w_ada[l] + b_ada[l]
        shift1, scale1, gate1, shift2, scale2, gate2 = jnp.split(mod, N_MOD, axis=-1)

        h = rms_norm(x, norm1_w[l]) * (1.0 + scale1[:, None]) + shift1[:, None]
        proj = h @ w_in[l]
        u_pool, q, k, v, g_a, g_b = jnp.split(proj, split_at, axis=-1)

        y_a = multiscale_pool(u_pool, w_pool[l], pool_scale[l]) @ w_a_up[l]

        q = rms_norm(q.reshape(B, S, SB_HEADS, SB_HEAD_DIM), q_norm_w[l])
        k = rms_norm(k.reshape(B, S, SB_HEADS, SB_HEAD_DIM), k_norm_w[l])
        v = v.reshape(B, S, SB_HEADS, SB_HEAD_DIM)
        y_b = stick_breaking_attention(q, k, v) @ w_b_up[l]

        merged = jax.nn.sigmoid(g_a) * y_a + jax.nn.sigmoid(g_b) * y_b
        x = x + gate1[:, None] * (merged @ w_o[l])

        h2 = rms_norm(x, norm2_w[l]) * (1.0 + scale2[:, None]) + shift2[:, None]
        f = jnp.square(jax.nn.relu(h2 @ w_ff1[l])) @ w_ff2[l]
        x = x + gate2[:, None] * f
    return x
```

```cpp
#include <hip/hip_runtime.h>
#include <hip/hip_cooperative_groups.h>
#include <cstdio>
#include <cstdint>
namespace cg = cooperative_groups;
#ifndef MK_N_LAUNCHES
#define MK_N_LAUNCHES 1
#endif
namespace pg8 {
#define PG8_LAS __attribute__((address_space(3)))
typedef unsigned short bf16_t;
typedef short bf16x8 __attribute__((ext_vector_type(8)));
typedef float f32x4 __attribute__((ext_vector_type(4)));
typedef unsigned u32x4 __attribute__((ext_vector_type(4)));
typedef int i32x4 __attribute__((ext_vector_type(4)));
typedef int i32x8 __attribute__((ext_vector_type(8)));
typedef unsigned u32x2 __attribute__((ext_vector_type(2)));
constexpr int BM = 256, BK = 64, HALF = 128, HTB = HALF * BK * 2  , STAGE_BYTES = 8 * HTB, NXCD = 8, WGM = 8;

__host__ __device__ __forceinline__ int lds_byte(int r, int c) { const int st = (r >> 4) * 2 + (c >> 5), rr = r & 15, cc = c & 31, ob = rr * 64 + cc * 2; return st * 1024 + (ob ^ (((ob >> 9) & 1) << 5)); }
__host__ __device__ __forceinline__ void stage_rc(int b, int& R, int& C) { const int st = b / 1024, sb = b % 1024, swz = sb ^ (((sb >> 9) & 1) << 5); R = (st >> 1) * 16 + swz / 64; C = (st & 1) * 32 + (swz % 64) / 2; }
__host__ __device__ __forceinline__ int perm32(int rho) { const int n = rho >> 4, i = rho & 15; return 8 * (i >> 2) + 4 * n + (i & 3); }

struct Unit { int pm, pn, kind; };
struct Gemm { const bf16_t* A; const bf16_t* Bt; int K, lda, ldb, a_pn_off, gap_at, gap, mid_t; const bf16_t* A2; const bf16_t* Bt2; };

struct StaticOrder {
    int nM, nN, nwg, G, c;
    __host__ __device__ void init(int M, int N, int G_, int c_) { nM = M / BM; nN = N / BM; nwg = nM * nN; G = G_; c = c_; }
    __host__ __device__ bool next(int i, Unit& u) const {
        const long L = (long)i * G + c; if (L >= nwg) return false;
        int wgid = (int)L; { const int q = nwg / NXCD, r = nwg % NXCD, xcd = wgid % NXCD, off = wgid / NXCD; wgid = (xcd < r ? xcd * (q + 1) : r * (q + 1) + (xcd - r) * q) + off; }
        const int nig = WGM * nN, gid = wgid / nig, fm = gid * WGM, gsz = (nM - fm) < WGM ? (nM - fm) : WGM;
        u.pm = fm + ((wgid % nig) % gsz); u.pn = (wgid % nig) / gsz; u.kind = 0; return true;
    }
    __device__ __forceinline__ void a_ready(const Unit&) const {}
    __device__ __forceinline__ void done(const Unit&) const {}
};
struct TwoGemmOrder {
    StaticOrder S0, S1; int G, c;
    __host__ __device__ void init(int M0, int N0, int M1, int N1, int G_, int c_) { S0.init(M0, N0, 1, 0); S1.init(M1, N1, 1, 0); G = G_; c = c_; }
    __host__ __device__ bool next(int i, Unit& u) const { const long L = (long)i * G + c;
        if (L < S0.nwg) return S0.next((int)L, u);
        if (L - S0.nwg < S1.nwg) { const bool ok = S1.next((int)(L - S0.nwg), u); u.kind = 1; return ok; }
        return false; }
    __device__ __forceinline__ void a_ready(const Unit&) const {}
    __device__ __forceinline__ void done(const Unit&) const {}
};


typedef float f32x2 __attribute__((ext_vector_type(2))); typedef __bf16 bf16x2_t __attribute__((ext_vector_type(2)));
__device__ __forceinline__ unsigned cvt_pk_bf16(float lo, float hi) { f32x2 v = {lo, hi}; bf16x2_t b = __builtin_convertvector(v, bf16x2_t); return __builtin_bit_cast(unsigned, b); }
__device__ __forceinline__ u32x4 pack8(f32x4 v0, f32x4 v1) { u32x4 w; w.x = cvt_pk_bf16(v0[0], v0[1]); w.y = cvt_pk_bf16(v0[2], v0[3]); w.z = cvt_pk_bf16(v1[0], v1[1]); w.w = cvt_pk_bf16(v1[2], v1[3]); return w; }
__device__ __forceinline__ float bf_lo(unsigned w) { return __uint_as_float(w << 16); }
__device__ __forceinline__ float bf_hi(unsigned w) { return __uint_as_float(w & 0xffff0000u); }
__device__ __forceinline__ float sigmoidf_(float x) { return __builtin_amdgcn_rcpf(1.0f + __expf(-x)); }

template <int MODE> struct EpiBf16 {
    static constexpr bool PERM = true, AFTER_DRAIN = false, HAS_MID = false;
    bf16_t* O; int ldc; const float* colscale;
    __device__ __forceinline__ void operator()(const f32x4 (&acc)[2][2][4][2], const Unit& u, int wr, int wc, int fr, int fq) const {
        const int row0 = u.pm * BM + wr * 64 + fr, col0 = u.pn * BM + wc * 32 + 8 * fq;
        f32x4 cs[2][2];
        if (MODE == 2) {
#pragma unroll
            for (int bj = 0; bj < 2; ++bj)
#pragma unroll
                for (int n = 0; n < 2; ++n) cs[bj][n] = *(const f32x4*)(colscale + col0 + bj * HALF + 4 * n);
        }
#pragma unroll
        for (int ai = 0; ai < 2; ++ai)
#pragma unroll
            for (int m = 0; m < 4; ++m) { bf16_t* rowp = O + (size_t)(row0 + ai * HALF + m * 16) * ldc + col0;
#pragma unroll
                for (int bj = 0; bj < 2; ++bj) { f32x4 v0 = acc[ai][bj][m][0], v1 = acc[ai][bj][m][1];
                    if (MODE == 1) {
#pragma unroll
                        for (int e = 0; e < 4; ++e) { const float a = fmaxf(v0[e], 0.f), b = fmaxf(v1[e], 0.f); v0[e] = a * a; v1[e] = b * b; } }
                    if (MODE == 2) { v0 = v0 * cs[bj][0]; v1 = v1 * cs[bj][1]; }
                    *(u32x4*)(rowp + bj * HALF) = pack8(v0, v1); } }
    }
};
struct EpiVF {
    static constexpr bool PERM = true, AFTER_DRAIN = false, HAS_MID = false;
    bf16_t* VF;
    __device__ __forceinline__ void operator()(const f32x4 (&acc)[2][2][4][2], const Unit& u, int wr, int wc, int fr, int fq) const {
        const int row0 = u.pm * BM + wr * 64 + fr, col0 = u.pn * BM + wc * 32 + 8 * fq;
#pragma unroll
        for (int ai = 0; ai < 2; ++ai)
#pragma unroll
            for (int m = 0; m < 4; ++m) { const int row = row0 + ai * HALF + m * 16, h = row >> 7, db = (row >> 5) & 3, r = row & 31;
#pragma unroll
                for (int bj = 0; bj < 2; ++bj) { const int c = col0 + bj * HALF, b = c >> 11, t = c & 2047, tile = t >> 5, s = (t >> 4) & 1, hh = (t >> 3) & 1;
                    const size_t off = ((((((size_t)(b * 8 + h) * 64 + tile) * 4 + db) * 2 + s) * 2 + hh) * 32 + r) * 8;
                    *(u32x4*)(VF + off) = pack8(acc[ai][bj][m][0], acc[ai][bj][m][1]); } }
    }
};
struct EpiP1 {
    static constexpr bool PERM = true, AFTER_DRAIN = false, HAS_MID = false;
    bf16_t* U; bf16_t* Q; bf16_t* KF; bf16_t* SG;
    __device__ __forceinline__ void operator()(const f32x4 (&acc)[2][2][4][2], const Unit& u, int wr, int wc, int fr, int fq) const {
        const int pn = u.pn + (u.pn >= 12 ? 4 : 0);
        const int row0 = u.pm * BM + wr * 64 + fr, cl = wc * 32 + 8 * fq;
        if (pn < 8) {
            bf16_t* base = pn < 4 ? U : Q; const int colt = (pn & 3) * 256;
#pragma unroll
            for (int ai = 0; ai < 2; ++ai)
#pragma unroll
                for (int m = 0; m < 4; ++m) { bf16_t* rowp = base + (size_t)(row0 + ai * HALF + m * 16) * 1024 + colt + cl;
#pragma unroll
                    for (int bj = 0; bj < 2; ++bj) *(u32x4*)(rowp + bj * HALF) = pack8(acc[ai][bj][m][0], acc[ai][bj][m][1]); }
        } else if (pn < 12) {
            const int sd = cl >> 4, hh = (cl >> 3) & 1;
#pragma unroll
            for (int ai = 0; ai < 2; ++ai)
#pragma unroll
                for (int m = 0; m < 4; ++m) { const int row = row0 + ai * HALF + m * 16, t = row & 2047, kk = t & 31, slot = (kk & ~12) | ((kk & 4) << 1) | ((kk & 8) >> 1);
#pragma unroll
                    for (int bj = 0; bj < 2; ++bj) { const int h = (pn - 8) * 2 + bj;
                        const size_t off = (((((size_t)((row >> 11) * 8 + h) * 64 + (t >> 5)) * 8 + sd) * 2 + hh) * 32 + slot) * 8;
                        *(u32x4*)(KF + off) = pack8(acc[ai][bj][m][0], acc[ai][bj][m][1]); } }
        } else {
            const int colt = (pn - 16) * 256;
            unsigned char* SG8 = (unsigned char*)SG;
#pragma unroll
            for (int ai = 0; ai < 2; ++ai)
#pragma unroll
                for (int m = 0; m < 4; ++m) { unsigned char* rowp = SG8 + (size_t)(row0 + ai * HALF + m * 16) * 4096 + colt + cl;
#pragma unroll
                    for (int bj = 0; bj < 2; ++bj) { const f32x4 v0 = acc[ai][bj][m][0], v1 = acc[ai][bj][m][1]; unsigned q[8];
#pragma unroll
                        for (int e = 0; e < 4; ++e) { q[e] = (unsigned)fminf(fmaxf(sigmoidf_(v0[e]) * 255.0f + 0.5f, 1.0f), 255.0f); q[4 + e] = (unsigned)fminf(fmaxf(sigmoidf_(v1[e]) * 255.0f + 0.5f, 1.0f), 255.0f); }
                        u32x2 w; w.x = q[0] | (q[1] << 8) | (q[2] << 16) | (q[3] << 24); w.y = q[4] | (q[5] << 8) | (q[6] << 16) | (q[7] << 24);
                        *(u32x2*)(rowp + bj * HALF) = w; } }
        }
    }
};
struct EpiGate8 {
    static constexpr bool PERM = false, AFTER_DRAIN = false, HAS_MID = false;
    unsigned char* SG8;
    __device__ __forceinline__ void operator()(const f32x4 (&acc)[2][2][4][2], const Unit& u, int wr, int wc, int fr, int fq) const {
        int t_ = threadIdx.x; asm volatile("" : "+v"(t_));
        const int l_ = t_ & 63, w_ = t_ >> 6; fr = l_ & 15; fq = l_ >> 4; wr = w_ >> 2; wc = w_ & 3;
        const int row0 = u.pm * BM + wr * 64 + fr, col0 = u.pn * BM + wc * 32 + 4 * fq;
#pragma unroll
        for (int ai = 0; ai < 2; ++ai)
#pragma unroll
            for (int m = 0; m < 4; ++m) { unsigned char* rowp = SG8 + (size_t)(row0 + ai * HALF + m * 16) * 4096 + col0;
#pragma unroll
                for (int bj = 0; bj < 2; ++bj)
#pragma unroll
                    for (int n = 0; n < 2; ++n) { const f32x4 v = acc[ai][bj][m][n] * 0.015625f; unsigned q[4];
#pragma unroll
                        for (int e = 0; e < 4; ++e) q[e] = (unsigned)fminf(fmaxf(sigmoidf_(v[e]) * 255.0f + 0.5f, 1.0f), 255.0f);
                        *(unsigned*)(rowp + bj * HALF + n * 16) = q[0] | (q[1] << 8) | (q[2] << 16) | (q[3] << 24); } }
    }
};
struct EpiP2 {
    static constexpr bool PERM = true, AFTER_DRAIN = false, HAS_MID = false;
    EpiP1 a; EpiVF b;
    __device__ __forceinline__ void operator()(const f32x4 (&acc)[2][2][4][2], const Unit& u, int wr, int wc, int fr, int fq) const { if (u.kind) b(acc, u, wr, wc, fr, fq); else a(acc, u, wr, wc, fr, fq); }
};
struct EpiGateMerge {
    static constexpr bool PERM = true, AFTER_DRAIN = false, HAS_MID = true;
    const unsigned char* SG8; bf16_t* O;
#define UB(w, i) ((float)(((w) >> (8 * (i))) & 0xffu))
    __device__ __forceinline__ void mid(f32x4 (&acc)[2][2][4][2], const Unit& u, int wr, int wc, int fr, int fq) const {
        const int row0 = u.pm * BM + wr * 64 + fr, col0 = u.pn * BM + wc * 32 + 8 * fq;
        const unsigned char* sp0 = SG8 + (size_t)row0 * 4096 + col0; asm volatile("" : "+v"(sp0));
#pragma unroll
        for (int ai = 0; ai < 2; ++ai)
#pragma unroll
            for (int m = 0; m < 4; ++m) { const unsigned char* sp = sp0 + (size_t)(ai * HALF + m * 16) * 4096;
#pragma unroll
                for (int bj = 0; bj < 2; ++bj) { const u32x2 ga = __builtin_nontemporal_load((const u32x2*)(sp + bj * HALF)), gb = __builtin_nontemporal_load((const u32x2*)(sp + 2048 + bj * HALF));
                    f32x4 r0, r1;
                    r0[0] = UB(gb.x, 0) * __builtin_amdgcn_rcpf(UB(ga.x, 0)); r0[1] = UB(gb.x, 1) * __builtin_amdgcn_rcpf(UB(ga.x, 1));
                    r0[2] = UB(gb.x, 2) * __builtin_amdgcn_rcpf(UB(ga.x, 2)); r0[3] = UB(gb.x, 3) * __builtin_amdgcn_rcpf(UB(ga.x, 3));
                    r1[0] = UB(gb.y, 0) * __builtin_amdgcn_rcpf(UB(ga.y, 0)); r1[1] = UB(gb.y, 1) * __builtin_amdgcn_rcpf(UB(ga.y, 1));
                    r1[2] = UB(gb.y, 2) * __builtin_amdgcn_rcpf(UB(ga.y, 2)); r1[3] = UB(gb.y, 3) * __builtin_amdgcn_rcpf(UB(ga.y, 3));
                    acc[ai][bj][m][0] *= r0; acc[ai][bj][m][1] *= r1; }
                if (m == 3) asm volatile("" ::: "memory"); }
    }
    __device__ __forceinline__ void operator()(const f32x4 (&acc)[2][2][4][2], const Unit& u, int wr, int wc, int fr, int fq) const {
        const int row0 = u.pm * BM + wr * 64 + fr, col0 = u.pn * BM + wc * 32 + 8 * fq;
        const float k = 1.0f / 255.0f;
#pragma unroll
        for (int ai = 0; ai < 2; ++ai)
#pragma unroll
            for (int m = 0; m < 4; ++m) { const size_t row = (size_t)(row0 + ai * HALF + m * 16);
#pragma unroll
                for (int bj = 0; bj < 2; ++bj) { const u32x2 g = __builtin_nontemporal_load((const u32x2*)(SG8 + row * 4096 + col0 + bj * HALF));
                    const f32x4 g0 = {UB(g.x, 0) * k, UB(g.x, 1) * k, UB(g.x, 2) * k, UB(g.x, 3) * k}, g1 = {UB(g.y, 0) * k, UB(g.y, 1) * k, UB(g.y, 2) * k, UB(g.y, 3) * k};
                    *(u32x4*)(O + row * 2048 + col0 + bj * HALF) = pack8(acc[ai][bj][m][0] * g0, acc[ai][bj][m][1] * g1); } }
    }
#undef UB
};
struct EpiResNorm {
    static constexpr bool PERM = true, AFTER_DRAIN = false, HAS_MID = false;
    const float* base; bf16_t* X1B; const float* mod; const float* nw; bf16_t* A2; float* rowsq;
    __device__ __forceinline__ void operator()(const f32x4 (&acc)[2][2][4][2], const Unit& u, int wr, int wc, int fr, int fq) const {
        const int row0 = u.pm * BM + wr * 64 + fr, col0 = u.pn * BM + wc * 32 + 8 * fq;
        const float* mb = mod + (size_t)(u.pm >> 3) * 12288 + col0;
        f32x4 gv[2][2], cs[2][2];
#pragma unroll
        for (int bj = 0; bj < 2; ++bj)
#pragma unroll
            for (int n = 0; n < 2; ++n) { gv[bj][n] = *(const f32x4*)(mb + 4096 + bj * HALF + 4 * n);
                cs[bj][n] = *(const f32x4*)(nw + col0 + bj * HALF + 4 * n) * (*(const f32x4*)(mb + 8192 + bj * HALF + 4 * n) + 1.0f); }
#pragma unroll
        for (int ai = 0; ai < 2; ++ai)
#pragma unroll
            for (int mp = 0; mp < 4; mp += 2) {
                f32x4 bs[2][2][2];
#pragma unroll
                for (int m2 = 0; m2 < 2; ++m2) { const size_t off = (size_t)(row0 + ai * HALF + (mp + m2) * 16) * 2048 + col0;
#pragma unroll
                    for (int bj = 0; bj < 2; ++bj)
#pragma unroll
                        for (int n = 0; n < 2; ++n) bs[m2][bj][n] = __builtin_nontemporal_load((const f32x4*)(base + off + bj * HALF + 4 * n)); }
                asm volatile("" ::: "memory");
#pragma unroll
                for (int m2 = 0; m2 < 2; ++m2) { const int row = row0 + ai * HALF + (mp + m2) * 16; const size_t off = (size_t)row * 2048 + col0; float q = 0.f;
#pragma unroll
                    for (int bj = 0; bj < 2; ++bj) { const f32x4 x0 = bs[m2][bj][0] + gv[bj][0] * acc[ai][bj][mp + m2][0], x1 = bs[m2][bj][1] + gv[bj][1] * acc[ai][bj][mp + m2][1];
                        *(u32x4*)(X1B + off + bj * HALF) = pack8(x0, x1);
                        q += ((x0[0] * x0[0] + x0[1] * x0[1]) + (x0[2] * x0[2] + x0[3] * x0[3])) + ((x1[0] * x1[0] + x1[1] * x1[1]) + (x1[2] * x1[2] + x1[3] * x1[3]));
                        *(u32x4*)(A2 + off + bj * HALF) = pack8(x0 * cs[bj][0], x1 * cs[bj][1]); }
                    q += __shfl_xor(q, 16); q += __shfl_xor(q, 32);
                    if (fq == 0) atomicAdd(rowsq + row, q); }
                asm volatile("" ::: "memory"); }
    }
};
struct EpiFF1 {
    static constexpr bool PERM = true, AFTER_DRAIN = false, HAS_MID = false;
    bf16_t* O; const float* rowsq; const float* bias2;
    __device__ __forceinline__ void operator()(const f32x4 (&acc)[2][2][4][2], const Unit& u, int wr, int wc, int fr, int fq) const {
        const int row0 = u.pm * BM + wr * 64 + fr, col0 = u.pn * BM + wc * 32 + 8 * fq;
        const float* bp = bias2 + (size_t)(u.pm >> 3) * 8192 + col0;
        float rs[2][4];
#pragma unroll
        for (int ai = 0; ai < 2; ++ai)
#pragma unroll
            for (int m = 0; m < 4; ++m) rs[ai][m] = rowsq[row0 + ai * HALF + m * 16];
        f32x4 bv[2][2];
#pragma unroll
        for (int bj = 0; bj < 2; ++bj)
#pragma unroll
            for (int n = 0; n < 2; ++n) bv[bj][n] = *(const f32x4*)(bp + bj * HALF + 4 * n);
#pragma unroll
        for (int ai = 0; ai < 2; ++ai)
#pragma unroll
            for (int m = 0; m < 4; ++m) { const float rstd = 1.0f / sqrtf(rs[ai][m] * (1.0f / 2048.0f) + 1e-6f);
                bf16_t* rowp = O + (size_t)(row0 + ai * HALF + m * 16) * 8192 + col0;
#pragma unroll
                for (int bj = 0; bj < 2; ++bj) { f32x4 v0 = acc[ai][bj][m][0] * rstd + bv[bj][0], v1 = acc[ai][bj][m][1] * rstd + bv[bj][1];
#pragma unroll
                    for (int e = 0; e < 4; ++e) { const float a = fmaxf(v0[e], 0.f), b = fmaxf(v1[e], 0.f); v0[e] = a * a; v1[e] = b * b; }
                    *(u32x4*)(rowp + bj * HALF) = pack8(v0, v1); } }
    }
};
struct EpiOut {
    static constexpr bool PERM = true, AFTER_DRAIN = false, HAS_MID = false;
    const bf16_t* X1B; float* out; const float* gate;
    __device__ __forceinline__ void operator()(const f32x4 (&acc)[2][2][4][2], const Unit& u, int wr, int wc, int fr, int fq) const {
        const int row0 = u.pm * BM + wr * 64 + fr, col0 = u.pn * BM + wc * 32 + 8 * fq;
        const float* gp = gate + (size_t)(u.pm >> 3) * 12288 + col0;
        f32x4 gv[2][2];
#pragma unroll
        for (int bj = 0; bj < 2; ++bj)
#pragma unroll
            for (int n = 0; n < 2; ++n) gv[bj][n] = *(const f32x4*)(gp + bj * HALF + 4 * n);
#pragma unroll
        for (int ai = 0; ai < 2; ++ai) {
            u32x4 xb[4][2];
#pragma unroll
            for (int m = 0; m < 4; ++m)
#pragma unroll
                for (int bj = 0; bj < 2; ++bj) xb[m][bj] = __builtin_nontemporal_load((const u32x4*)(X1B + (size_t)(row0 + ai * HALF + m * 16) * 2048 + col0 + bj * HALF));
#pragma unroll
            for (int m = 0; m < 4; ++m) { float* op = out + (size_t)(row0 + ai * HALF + m * 16) * 2048 + col0;
#pragma unroll
                for (int bj = 0; bj < 2; ++bj) { const u32x4 g = xb[m][bj];
                    const f32x4 x0 = {bf_lo(g.x), bf_hi(g.x), bf_lo(g.y), bf_hi(g.y)}, x1 = {bf_lo(g.z), bf_hi(g.z), bf_lo(g.w), bf_hi(g.w)};
                    *(f32x4*)(op + bj * HALF) = x0 + gv[bj][0] * acc[ai][bj][m][0]; *(f32x4*)(op + bj * HALF + 4) = x1 + gv[bj][1] * acc[ai][bj][m][1]; } }
        }
    }
};
struct EpiRes {
    static constexpr bool PERM = false, AFTER_DRAIN = false, HAS_MID = false;
    const float* base; float* out; const float* gate;
    __device__ __forceinline__ void operator()(const f32x4 (&acc)[2][2][4][2], const Unit& u, int wr, int wc, int fr, int fq) const {
        const int row0 = u.pm * BM + wr * 64 + fr, col0 = u.pn * BM + wc * 32 + 4 * fq;
        const float* gp = gate + (size_t)(u.pm >> 3) * 12288 + col0;
        f32x4 gv[2][2];
#pragma unroll
        for (int bj = 0; bj < 2; ++bj)
#pragma unroll
            for (int n = 0; n < 2; ++n) gv[bj][n] = *(const f32x4*)(gp + bj * HALF + n * 16);
#pragma unroll
        for (int ai = 0; ai < 2; ++ai)
#pragma unroll
            for (int m = 0; m < 4; ++m) { const size_t off = (size_t)(row0 + ai * HALF + m * 16) * 2048 + col0;
#pragma unroll
                for (int bj = 0; bj < 2; ++bj)
#pragma unroll
                    for (int n = 0; n < 2; ++n) { const f32x4 bs = __builtin_nontemporal_load((const f32x4*)(base + off + bj * HALF + n * 16)); *(f32x4*)(out + off + bj * HALF + n * 16) = bs + gv[bj][n] * acc[ai][bj][m][n]; } }
    }
};
template <class Epi, class Sched, bool ALIGN_EPI = false, bool SP2 = false, bool FP8 = false>
__device__ __forceinline__ void gemm_phase(PG8_LAS unsigned char* lds, const Gemm g, const Sched& S, const Epi& E) {
    int tid_ = threadIdx.x; asm volatile("" : "+v"(tid_));
    const int tid = tid_, wid = __builtin_amdgcn_readfirstlane(tid >> 6), lane = tid & 63, wr = wid >> 2, wc = wid & 3, fr = lane & 15, fq = lane >> 4;
    const int K = g.K, nt = K / BK;
    unsigned voffA[1], voffB[1];
    { int R, C; stage_rc(tid * 16, R, C); const int Rb = Epi::PERM ? ((R & ~31) + perm32(R & 31)) : R;
      voffA[0] = (unsigned)(R * g.lda + C) * 2u; voffB[0] = (unsigned)(Rb * g.ldb + C) * 2u; }
    const size_t voffA_step = (size_t)64 * g.lda * 2, voffB_step = (size_t)64 * g.ldb * 2;
    const size_t kstep = (size_t)(BK * 2);
    const size_t hstepA = (size_t)HALF * g.lda * 2, hstepB = (size_t)HALF * g.ldb * 2;
    const size_t tstepA = 2 * hstepA, tstepB = 2 * hstepB;
#define PG8_APTR(u) ((u).kind ? (const char*)g.A2 + (size_t)(u).pm * tstepA : (const char*)g.A + (size_t)(u).pm * tstepA + (size_t)(u).pn * (size_t)g.a_pn_off * 2)
#define PG8_BPTR(u) ((u).kind ? (const char*)g.Bt2 + (size_t)(u).pn * tstepB : (const char*)g.Bt + (size_t)((u).pn + ((u).pn >= g.gap_at ? g.gap : 0)) * tstepB)
    const unsigned ldsw = (unsigned)wid * 1024u;
    const int aoff = lds_byte(wr * 64 + fr, fq * 8), boff = lds_byte(wc * 32 + fr, fq * 8);
#define PG8_SA(b, h) (((b) * 2 + (h)) * HTB)
#define PG8_SB(b, h) ((4 + (b) * 2 + (h)) * HTB)
#define PG8_STAGE(bufoff, gbase, voff) do { _Pragma("unroll") for (int _i = 0; _i < 2; ++_i) \
        __builtin_amdgcn_global_load_lds((const unsigned*)((const char*)(gbase) + (size_t)_i * voff##_step + (voff)[0]), (PG8_LAS unsigned*)(lds + (bufoff) + ldsw + _i * 8192), 16, 0, 0); } while (0)
#define PG8_LDA(dst, b, h) do { if constexpr (FP8) { _Pragma("unroll") for (int m = 0; m < 4; ++m) dst##8[m] = __builtin_shufflevector(*(const PG8_LAS i32x4*)(lds + PG8_SA(b, h) + aoff + m * 2048), *(const PG8_LAS i32x4*)(lds + PG8_SA(b, h) + aoff + m * 2048 + 1024), 0, 1, 2, 3, 4, 5, 6, 7); } \
    else { _Pragma("unroll") for (int m = 0; m < 4; ++m) _Pragma("unroll") for (int k = 0; k < 2; ++k) dst[m][k] = *(const PG8_LAS bf16x8*)(lds + PG8_SA(b, h) + aoff + m * 2048 + k * 1024); } } while (0)
#define PG8_LDB(dst, b, h) do { if constexpr (FP8) { _Pragma("unroll") for (int n = 0; n < 2; ++n) dst##8[n] = __builtin_shufflevector(*(const PG8_LAS i32x4*)(lds + PG8_SB(b, h) + boff + n * 2048), *(const PG8_LAS i32x4*)(lds + PG8_SB(b, h) + boff + n * 2048 + 1024), 0, 1, 2, 3, 4, 5, 6, 7); } \
    else { _Pragma("unroll") for (int n = 0; n < 2; ++n) _Pragma("unroll") for (int k = 0; k < 2; ++k) dst[n][k] = *(const PG8_LAS bf16x8*)(lds + PG8_SB(b, h) + boff + n * 2048 + k * 1024); } } while (0)
#define PG8_MMA(ai, bj, At, Bt) do { __builtin_amdgcn_s_setprio(1); if constexpr (FP8) { _Pragma("unroll") for (int m = 0; m < 4; ++m) _Pragma("unroll") for (int n = 0; n < 2; ++n) \
        acc[ai][bj][m][n] = __builtin_amdgcn_mfma_scale_f32_16x16x128_f8f6f4(Bt##8[n], At##8[m], acc[ai][bj][m][n], 0, 0, 0, 0x7f7f7f7f, 0, 0x7f7f7f7f); } else { \
        _Pragma("unroll") for (int m = 0; m < 4; ++m) _Pragma("unroll") for (int n = 0; n < 2; ++n) _Pragma("unroll") for (int k = 0; k < 2; ++k) \
        acc[ai][bj][m][n] = __builtin_amdgcn_mfma_f32_16x16x32_bf16(Bt[n][k], At[m][k], acc[ai][bj][m][n], 0, 0, 0); } __builtin_amdgcn_s_setprio(0); } while (0)
#define PG8_WAIT_V(n) asm volatile("s_waitcnt vmcnt(" #n ")" ::: "memory")
#define PG8_WAIT_L(n) asm volatile("s_waitcnt lgkmcnt(" #n ")" ::: "memory")
#define PG8_BAR __builtin_amdgcn_s_barrier()
#define PG8_SCHED __builtin_amdgcn_sched_barrier(0)
    Unit cur, nxt; int ui = 0;
    if (!S.next(0, cur)) return;
    f32x4 acc[2][2][4][2];
#pragma unroll
    for (int a = 0; a < 2; ++a)
#pragma unroll
        for (int b = 0; b < 2; ++b)
#pragma unroll
            for (int m = 0; m < 4; ++m)
#pragma unroll
                for (int n = 0; n < 2; ++n) acc[a][b][m][n] = (f32x4){0.f, 0.f, 0.f, 0.f};
    bf16x8 At[4][2], B0[2][2], B1[2][2]; i32x8 At8[4], B08[2], B18[2];
    const char* cA = PG8_APTR(cur); const char* cB = PG8_BPTR(cur);
    S.a_ready(cur);
    if constexpr (SP2) {
        PG8_STAGE(PG8_SB(0, 0), cB, voffB); PG8_STAGE(PG8_SB(0, 1), cB + hstepB, voffB); PG8_STAGE(PG8_SA(0, 0), cA, voffA); PG8_STAGE(PG8_SA(0, 1), cA + hstepA, voffA);
        if (wr == 1) PG8_BAR;
        PG8_WAIT_V(2); PG8_BAR;
        PG8_STAGE(PG8_SB(1, 0), cB + kstep, voffB); PG8_STAGE(PG8_SA(1, 0), cA + kstep, voffA); PG8_STAGE(PG8_SB(1, 1), cB + hstepB + kstep, voffB);
        PG8_WAIT_V(6); PG8_BAR;
    } else {
        PG8_STAGE(PG8_SB(0, 0), cB, voffB); PG8_STAGE(PG8_SA(0, 0), cA, voffA); PG8_STAGE(PG8_SB(0, 1), cB + hstepB, voffB); PG8_STAGE(PG8_SA(0, 1), cA + hstepA, voffA);
        if (wr == 1) PG8_BAR;
        PG8_WAIT_V(4); PG8_BAR;
        PG8_STAGE(PG8_SB(1, 0), cB + kstep, voffB); PG8_STAGE(PG8_SA(1, 0), cA + kstep, voffA); PG8_STAGE(PG8_SB(1, 1), cB + hstepB + kstep, voffB);
        PG8_WAIT_V(6); PG8_BAR;
    }
    for (;;) {
        const bool has_next = S.next(ui + 1, nxt);
        const char* nA = has_next ? PG8_APTR(nxt) : cA; const char* nB = has_next ? PG8_BPTR(nxt) : cB;
        for (int t = 0; t < nt; t += 2) {
            if constexpr (Epi::HAS_MID) { if (t == g.mid_t) E.mid(acc, cur, wr, wc, fr, fq); }
            const bool last = (t == nt - 2);
            const char* a1 = cA + (size_t)(t + 1) * kstep;
            const char* a2 = last ? nA : cA + (size_t)(t + 2) * kstep; const char* b2 = last ? nB : cB + (size_t)(t + 2) * kstep;
            const char* a3 = a2 + kstep; const char* b3 = b2 + kstep;
            if (last && has_next) S.a_ready(nxt);
            if constexpr (SP2) {
            PG8_LDB(B0, 0, 0); PG8_LDB(B1, 0, 1); PG8_SCHED; PG8_LDA(At, 0, 0); PG8_STAGE(PG8_SA(1, 1), a1 + hstepA, voffA);
            PG8_WAIT_V(8); PG8_WAIT_L(0); PG8_BAR; PG8_MMA(0, 0, At, B0); PG8_MMA(0, 1, At, B1); PG8_BAR; PG8_SCHED;
            PG8_LDA(At, 0, 1); PG8_STAGE(PG8_SB(0, 0), b2, voffB); PG8_STAGE(PG8_SB(0, 1), b2 + hstepB, voffB); PG8_STAGE(PG8_SA(0, 0), a2, voffA);
            PG8_WAIT_V(8); PG8_WAIT_L(0); PG8_BAR; PG8_MMA(1, 0, At, B0); PG8_MMA(1, 1, At, B1); PG8_BAR; PG8_SCHED;
            PG8_LDB(B0, 1, 0); PG8_LDB(B1, 1, 1); PG8_SCHED; PG8_LDA(At, 1, 0); PG8_STAGE(PG8_SA(0, 1), a2 + hstepA, voffA);
            PG8_WAIT_V(8); PG8_WAIT_L(0); PG8_BAR; PG8_MMA(0, 0, At, B0); PG8_MMA(0, 1, At, B1); PG8_BAR; PG8_SCHED;
            PG8_LDA(At, 1, 1); PG8_STAGE(PG8_SB(1, 0), b3, voffB); PG8_STAGE(PG8_SB(1, 1), b3 + hstepB, voffB); PG8_STAGE(PG8_SA(1, 0), a3, voffA);
            PG8_WAIT_V(8); PG8_WAIT_L(0); PG8_BAR; PG8_MMA(1, 0, At, B0); PG8_MMA(1, 1, At, B1); PG8_BAR; PG8_SCHED;
            } else {
            PG8_LDB(B0, 0, 0); PG8_SCHED; PG8_LDA(At, 0, 0); PG8_STAGE(PG8_SA(1, 1), a1 + hstepA, voffA);
            PG8_WAIT_L(8); PG8_BAR; PG8_WAIT_L(0); PG8_MMA(0, 0, At, B0); PG8_BAR; PG8_SCHED;
            PG8_LDB(B1, 0, 1); PG8_STAGE(PG8_SB(0, 0), b2, voffB);
            PG8_BAR; PG8_WAIT_L(0); PG8_MMA(0, 1, At, B1); PG8_BAR;
            PG8_LDA(At, 0, 1); PG8_STAGE(PG8_SA(0, 0), a2, voffA);
            PG8_BAR; PG8_WAIT_L(0); PG8_MMA(1, 0, At, B0); PG8_BAR; PG8_SCHED;
            PG8_STAGE(PG8_SB(0, 1), b2 + hstepB, voffB);
            PG8_WAIT_V(6); PG8_BAR; PG8_MMA(1, 1, At, B1); PG8_BAR;
            PG8_LDB(B0, 1, 0); PG8_SCHED; PG8_LDA(At, 1, 0); PG8_STAGE(PG8_SA(0, 1), a2 + hstepA, voffA);
            PG8_WAIT_L(8); PG8_BAR; PG8_WAIT_L(0); PG8_MMA(0, 0, At, B0); PG8_BAR; PG8_SCHED;
            PG8_LDB(B1, 1, 1); PG8_STAGE(PG8_SB(1, 0), b3, voffB);
            PG8_BAR; PG8_WAIT_L(0); PG8_MMA(0, 1, At, B1); PG8_BAR;
            PG8_LDA(At, 1, 1); PG8_STAGE(PG8_SA(1, 0), a3, voffA);
            PG8_BAR; PG8_WAIT_L(0); PG8_MMA(1, 0, At, B0); PG8_BAR; PG8_SCHED;
            PG8_STAGE(PG8_SB(1, 1), b3 + hstepB, voffB);
            PG8_WAIT_V(6); PG8_BAR; PG8_MMA(1, 1, At, B1); PG8_BAR;
            }
        }
        if constexpr (ALIGN_EPI) { if (wr == 0) PG8_BAR; }
        if constexpr (!Epi::AFTER_DRAIN) { E(acc, cur, wr, wc, fr, fq); S.done(cur); }
        if (!has_next) break;
#pragma unroll
        for (int a = 0; a < 2; ++a)
#pragma unroll
            for (int b = 0; b < 2; ++b)
#pragma unroll
                for (int m = 0; m < 4; ++m)
#pragma unroll
                    for (int n = 0; n < 2; ++n) acc[a][b][m][n] = (f32x4){0.f, 0.f, 0.f, 0.f};
        cur = nxt; cA = nA; cB = nB; ++ui;
        if constexpr (ALIGN_EPI) { if (wr == 1) PG8_BAR; }
    }
    PG8_WAIT_V(0);
    if constexpr (!ALIGN_EPI) { if (wr == 0) PG8_BAR; }
    PG8_BAR;
    if constexpr (Epi::AFTER_DRAIN) { E.fused(acc, cur, wr, wc, fr, fq, lds, wid, lane); S.done(cur); }
#undef PG8_APTR
#undef PG8_BPTR
#undef PG8_SA
#undef PG8_SB
#undef PG8_STAGE
#undef PG8_LDA
#undef PG8_LDB
#undef PG8_MMA
#undef PG8_WAIT_V
#undef PG8_WAIT_L
#undef PG8_BAR
#undef PG8_SCHED
}
}

constexpr int NWAVES = 8, NTHREADS = NWAVES * 64;
constexpr int BATCH = 4, SEQ = 2048, DM = 2048, MTOK = BATCH * SEQ;
constexpr int PW = 1024, SBW = 1024, NH = 8, HD = 128, INW = 8192, DFF = 8192, NMOD = 6 * DM;
constexpr float EPS = 1e-6f;
constexpr size_t MiB = 1u << 20;
constexpr size_t WS_MOD = 0;
constexpr size_t CTL_ZERO_BYTES = 256 * 1024;
constexpr size_t WS_QUEUE = 196 * 1024;
constexpr size_t WS_BAR = 200 * 1024;
constexpr size_t WS_ROWSQ = 216 * 1024;
constexpr size_t WS_BIAS2 = 113 * MiB + 512 * 1024;
constexpr size_t WS_X1B = 306 * MiB;
constexpr size_t WS_A2 = 274 * MiB;
constexpr size_t WS_WIN = 1 * MiB, WS_WFF1 = 33 * MiB, WS_WFF2 = 65 * MiB, WS_WO = 97 * MiB, WS_WBA = 105 * MiB, WS_WPOOL = 113 * MiB;
constexpr size_t WS_H = 114 * MiB;
constexpr size_t WS_R = 146 * MiB;
constexpr size_t WS_U = WS_R, WS_Q = WS_R + 32 * MiB, WS_K = WS_R + 48 * MiB, WS_VT = WS_R + 64 * MiB, WS_POOLED = WS_R + 80 * MiB, WS_AM = WS_R + 96 * MiB;
constexpr size_t WS_F1 = WS_R;
constexpr size_t WS_SG = 274 * MiB, WS_H8 = 338 * MiB, WS_END = 354 * MiB;
constexpr size_t WS_WG8 = WS_WIN + 16 * MiB;
constexpr int LDS_BYTES = 131072 + 1024;

#define LAS __attribute__((address_space(3)))
typedef unsigned short bf16;
typedef unsigned v4u __attribute__((ext_vector_type(4)));
typedef unsigned v2u __attribute__((ext_vector_type(2)));
typedef float f32x4 __attribute__((ext_vector_type(4)));
typedef float f32x16 __attribute__((ext_vector_type(16)));
typedef short bf16x8 __attribute__((ext_vector_type(8)));
#define LDS_WAIT() asm volatile("s_waitcnt lgkmcnt(0)" ::: "memory")
using pg8::cvt_pk_bf16;

__device__ __forceinline__ float wave_sum(float v) {
#pragma unroll
    for (int o = 1; o < 64; o <<= 1) v += __shfl_xor(v, o);
    return v;
}
__device__ __forceinline__ void p0_transpose_item(const float* W, int K, int N, bf16* WT, int ldt, LAS unsigned short* T, int item, int lane) {
    const int nblk = N / 64, kb = item / nblk, nb = item % nblk, k0 = 64 * kb, n0 = 64 * nb;
    const int row = lane >> 4, n4 = lane & 15;
    f32x4 v[16];
#pragma unroll
    for (int i = 0; i < 16; ++i) v[i] = __builtin_nontemporal_load((const f32x4*)(W + (size_t)(k0 + 4 * i + row) * N + n0 + 4 * n4));
#pragma unroll
    for (int i = 0; i < 16; ++i) { const int k = 4 * i + row; const unsigned p01 = cvt_pk_bf16(v[i].x, v[i].y), p23 = cvt_pk_bf16(v[i].z, v[i].w);
        T[(4 * n4 + 0) * 66 + k] = (unsigned short)p01; T[(4 * n4 + 1) * 66 + k] = (unsigned short)(p01 >> 16);
        T[(4 * n4 + 2) * 66 + k] = (unsigned short)p23; T[(4 * n4 + 3) * 66 + k] = (unsigned short)(p23 >> 16); }
    LDS_WAIT(); asm volatile("" ::: "memory");
    const int kc = lane & 7;
#pragma unroll
    for (int j = 0; j < 8; ++j) { const int n = (lane >> 3) + 8 * j; const LAS unsigned* tp = (const LAS unsigned*)(T + n * 66 + 8 * kc);
        v4u o; o.x = tp[0]; o.y = tp[1]; o.z = tp[2]; o.w = tp[3];
        *(v4u*)(WT + (size_t)(n0 + n) * ldt + k0 + 8 * kc) = o; }
    LDS_WAIT(); asm volatile("" ::: "memory");
}


#define XB_TMO      128
#define XB_XCNT(j)  (256  + 64 * (j))
#define XB_XSUB(j)  (1280 + 64 * (j))
#define XB_XGEN(j)  (2304 + 64 * (j))
#define XB_TOP      3328
#define XB_TOPGEN   3392
#define XCD_BAR_WORDS 3456
#define XB_SPIN_CAP (1u << 18)

__device__ __forceinline__ unsigned xb_ld(unsigned* p)              { return __hip_atomic_load(p, __ATOMIC_RELAXED, __HIP_MEMORY_SCOPE_AGENT); }
__device__ __forceinline__ unsigned xb_add(unsigned* p, unsigned v) { return __hip_atomic_fetch_add(p, v, __ATOMIC_RELAXED, __HIP_MEMORY_SCOPE_AGENT); }
__device__ __forceinline__ unsigned xb_xcc_id() { return (unsigned)__builtin_amdgcn_s_getreg((3 << 11) | 20) & 0xFu; }
#define XB_SPIN(cond, bar) do { unsigned _sp = 0; while (cond) { __builtin_amdgcn_s_sleep(1); \
    if ((++_sp & 255u) == 0u) { if (xb_ld(&(bar)[XB_TMO])) break; if (_sp > XB_SPIN_CAP) { atomicAdd(&(bar)[XB_TMO], 1u); break; } } } } while (0)

struct XcdBarrier {
    unsigned* bar; unsigned x;
    volatile LAS unsigned* st;
};

__device__ __forceinline__ XcdBarrier xcd_barrier_post(unsigned* bar, volatile LAS unsigned* st) {
    XcdBarrier b; b.bar = bar; b.x = xb_xcc_id(); b.st = st;
    if (threadIdx.x == 0) (void)xb_add(&bar[XB_XCNT(b.x)], 1u);
    return b;
}
__device__ __forceinline__ void xcd_barrier_complete(unsigned* bar, unsigned x, unsigned& nloc, unsigned& nx) {
    const unsigned G = gridDim.x * gridDim.y * gridDim.z;
    unsigned sum, cnt, mine, sp = 0u;
    for (;;) {
        sum = 0u; cnt = 0u; mine = 0u;
#pragma unroll
        for (unsigned j = 0; j < 16; ++j) { const unsigned c = xb_ld(&bar[XB_XCNT(j)]); sum += c; cnt += (c > 0u) ? 1u : 0u; mine = (j == x) ? c : mine; }
        if (sum == G) break;
        __builtin_amdgcn_s_sleep(1);
        if ((++sp & 255u) == 0u) { if (xb_ld(&bar[XB_TMO])) break; if (sp > XB_SPIN_CAP) { atomicAdd(&bar[XB_TMO], 1u); break; } }
    }
    nloc = mine > 0u ? mine : 1u; nx = cnt > 0u ? cnt : 1u;
}

__device__ __forceinline__ void xcd_barrier(const XcdBarrier& b) {
    asm volatile("s_waitcnt vmcnt(0)" ::: "memory");
    __syncthreads();
    if (threadIdx.x == 0) {
        unsigned* bar = b.bar;
        __builtin_amdgcn_s_waitcnt(0);
        unsigned nloc = b.st[0], nx = b.st[1];
        if (nloc == 0u) { xcd_barrier_complete(bar, b.x, nloc, nx); b.st[0] = nloc; b.st[1] = nx; }
        const unsigned old = xb_add(&bar[XB_XSUB(b.x)], 1u);
        const unsigned gen = old / nloc;
        if (old + 1u == (gen + 1u) * nloc) {
            __builtin_amdgcn_fence(__ATOMIC_RELEASE, "agent");
            asm volatile("s_waitcnt vmcnt(0)" ::: "memory");
            const unsigned og = xb_add(&bar[XB_TOP], 1u);
            const unsigned tg = og / nx;
            if (og + 1u == (tg + 1u) * nx) xb_add(&bar[XB_TOPGEN], 1u);
            else XB_SPIN(xb_ld(&bar[XB_TOPGEN]) == tg, bar);
            __builtin_amdgcn_fence(__ATOMIC_ACQUIRE, "agent");
            xb_add(&bar[XB_XGEN(b.x)], 1u);
            asm volatile("s_waitcnt vmcnt(0)" ::: "memory");
        } else {
            XB_SPIN(xb_ld(&bar[XB_XGEN(b.x)]) == gen, bar);
            __builtin_amdgcn_fence(__ATOMIC_ACQUIRE, "agent");
            asm volatile("s_waitcnt vmcnt(0)" ::: "memory");
        }
    }
    __syncthreads();
}

struct Args { const float* in[16]; float* out; unsigned char* ws; int ph_lo, ph_hi; };

__device__ __forceinline__ void p0_transpose_item_f8(const float* W, int N, unsigned char* W8, int ld8, int ncol0, LAS unsigned short* T, int item, int lane) {
    const int nblk = N / 64, kb = item / nblk, nb = item % nblk, k0 = 64 * kb, n0 = 64 * nb;
    const int row = lane >> 4, n4 = lane & 15;
    f32x4 v[16];
#pragma unroll
    for (int i = 0; i < 16; ++i) v[i] = __builtin_nontemporal_load((const f32x4*)(W + (size_t)(k0 + 4 * i + row) * N + n0 + 4 * n4));
#pragma unroll
    for (int i = 0; i < 16; ++i) { const int k = 4 * i + row; const unsigned p01 = cvt_pk_bf16(v[i].x, v[i].y), p23 = cvt_pk_bf16(v[i].z, v[i].w);
        T[(4 * n4 + 0) * 66 + k] = (unsigned short)p01; T[(4 * n4 + 1) * 66 + k] = (unsigned short)(p01 >> 16);
        T[(4 * n4 + 2) * 66 + k] = (unsigned short)p23; T[(4 * n4 + 3) * 66 + k] = (unsigned short)(p23 >> 16); }
    LDS_WAIT(); asm volatile("" ::: "memory");
    const int pc = lane & 3;
#pragma unroll
    for (int j = 0; j < 4; ++j) { const int n = (lane >> 2) + 16 * j; const LAS unsigned* tp = (const LAS unsigned*)(T + n * 66 + 16 * pc);
        v4u o;
#pragma unroll
        for (int d = 0; d < 4; ++d) { const unsigned w0 = tp[2 * d], w1 = tp[2 * d + 1];
            int p = __builtin_amdgcn_cvt_pk_fp8_f32(pg8::bf_lo(w0) * 64.0f, pg8::bf_hi(w0) * 64.0f, 0, false);
            p = __builtin_amdgcn_cvt_pk_fp8_f32(pg8::bf_lo(w1) * 64.0f, pg8::bf_hi(w1) * 64.0f, p, true); o[d] = (unsigned)p; }
        *(v4u*)(W8 + (size_t)(n0 - ncol0 + n) * ld8 + k0 + 16 * pc) = o; }
    LDS_WAIT(); asm volatile("" ::: "memory");
}

__device__ __forceinline__ void phase0(const Args& a, LAS unsigned char* lds, int tid, int lane, int wave, int G, bool do_atomics) {
    const float* c = a.in[1]; const float* w_ada = a.in[2]; const float* b_ada = a.in[3];
    float* mod = (float*)(a.ws + WS_MOD);
    unsigned* qhead = (unsigned*)(a.ws + WS_QUEUE) + (do_atomics ? 0 : 64);
    LAS float* sc = (LAS float*)lds;
    LAS float* red = (LAS float*)(lds + 8192);
    LAS unsigned short* T = (LAS unsigned short*)(lds + 8192 + wave * 8448);
    volatile LAS unsigned* slot = (volatile LAS unsigned*)(lds + 131072 + 512);
    constexpr int I_IN = (DM / 64) * (INW / 64), I_F1 = (DM / 64) * (DFF / 64), I_F2 = (DFF / 64) * (DM / 64), I_O = (DM / 64) * (DM / 64), I_A = (PW / 64) * (DM / 64), I_B = (SBW / 64) * (DM / 64), I_P = 4 * 4 * 4;
    constexpr int NITEMS = I_IN + I_F1 + I_F2 + I_O + I_A + I_B + I_P, NROUNDS = 192 + NITEMS / 8;
    static_assert(NITEMS % 8 == 0, "transpose items come in rounds of 8 (one per wave)");
    for (;;) {
        __syncthreads();
        if (tid == 0) slot[0] = __hip_atomic_fetch_add(qhead, 1u, __ATOMIC_RELAXED, __HIP_MEMORY_SCOPE_AGENT);
        __syncthreads();
        const int rd = (int)slot[0];
        if (rd >= NROUNDS) break;
        if (rd < 192) {
            const int cc = rd % 48, kc = rd / 48;
            for (int idx = tid; idx < 2048; idx += NTHREADS) { const float cv = c[(idx >> 9) * DM + kc * 512 + (idx & 511)]; sc[idx] = cv / (1.0f + __expf(-cv)); }
            __syncthreads();
            f32x4 acc[4];
#pragma unroll
            for (int b = 0; b < 4; ++b) acc[b] = (f32x4){0.f, 0.f, 0.f, 0.f};
            const float* wp = w_ada + (size_t)(kc * 512 + wave * 64) * NMOD + cc * 256 + lane * 4;
#pragma unroll 8
            for (int i = 0; i < 64; ++i) { const f32x4 w4 = __builtin_nontemporal_load((const f32x4*)(wp + (size_t)i * NMOD));
#pragma unroll
                for (int b = 0; b < 4; ++b) acc[b] += sc[b * 512 + wave * 64 + i] * w4; }
#pragma unroll
            for (int b = 0; b < 4; ++b) *(LAS f32x4*)(red + (wave * 4 + b) * 256 + lane * 4) = acc[b];
            __syncthreads();
#pragma unroll
            for (int e = 0; e < 2; ++e) { const int idx = tid + 512 * e, b = idx >> 8, col = idx & 255; float s = 0.f;
#pragma unroll
                for (int w = 0; w < 8; ++w) s += red[(w * 4 + b) * 256 + col];
                if (kc == 0) s += b_ada[cc * 256 + col];
                if (do_atomics) atomicAdd(mod + b * NMOD + cc * 256 + col, s); }
        } else {
            int r = (rd - 192) * 8 + wave;
            if (r < I_IN) { if ((r % (INW / 64)) >= 64) p0_transpose_item_f8(a.in[5], INW, a.ws + WS_WG8, DM, 4096, T, r, lane);
                            else p0_transpose_item(a.in[5], DM, INW, (bf16*)(a.ws + WS_WIN), DM, T, r, lane); continue; } r -= I_IN;
            if (r < I_F1) { p0_transpose_item(a.in[14], DM, DFF, (bf16*)(a.ws + WS_WFF1), DM, T, r, lane); continue; } r -= I_F1;
            if (r < I_F2) { p0_transpose_item(a.in[15], DFF, DM, (bf16*)(a.ws + WS_WFF2), DFF, T, r, lane); continue; } r -= I_F2;
            if (r < I_O) { p0_transpose_item(a.in[12], DM, DM, (bf16*)(a.ws + WS_WO), DM, T, r, lane); continue; } r -= I_O;
            if (r < I_A) { p0_transpose_item(a.in[10], PW, DM, (bf16*)(a.ws + WS_WBA) + SBW, DM, T, r, lane); continue; } r -= I_A;
            if (r < I_B) { p0_transpose_item(a.in[11], SBW, DM, (bf16*)(a.ws + WS_WBA), DM, T, r, lane); continue; } r -= I_B;
            { const int g = r >> 4; p0_transpose_item(a.in[8] + (size_t)g * 65536, 256, 256, (bf16*)(a.ws + WS_WPOOL) + (size_t)g * 65536, 256, T, r & 15, lane); }
        }
    }
}

__device__ __forceinline__ void norm_mod_rows(const float* X, const float* nw, const float* mod, int shift_off, int scale_off, bf16* O, unsigned char* O8, int lane, int gw, int NGW) {
    for (int m0 = gw * 4; m0 < MTOK; m0 += NGW * 4) {
        const float* mb = mod + (size_t)(m0 >> 11) * NMOD;
        f32x4 cs[8], sh[8];
#pragma unroll
        for (int j = 0; j < 8; ++j) { const int col = 4 * (lane + 64 * j); cs[j] = *(const f32x4*)(nw + col) * (*(const f32x4*)(mb + scale_off + col) + 1.0f); sh[j] = *(const f32x4*)(mb + shift_off + col); }
#pragma unroll 1
        for (int hr = 0; hr < 4; hr += 2) {
            f32x4 v[2][8];
#pragma unroll
            for (int r = 0; r < 2; ++r)
#pragma unroll
                for (int j = 0; j < 8; ++j) v[r][j] = __builtin_nontemporal_load((const f32x4*)(X + (size_t)(m0 + hr + r) * DM) + lane + 64 * j);
            float ss[2];
#pragma unroll
            for (int r = 0; r < 2; ++r) { float s = 0.f;
#pragma unroll
                for (int j = 0; j < 8; ++j) s += (v[r][j].x * v[r][j].x + v[r][j].y * v[r][j].y) + (v[r][j].z * v[r][j].z + v[r][j].w * v[r][j].w);
                ss[r] = s; }
#pragma unroll
            for (int o = 1; o < 64; o <<= 1) { ss[0] += __shfl_xor(ss[0], o); ss[1] += __shfl_xor(ss[1], o); }
#pragma unroll
            for (int r = 0; r < 2; ++r) { const float rstd = 1.0f / sqrtf(ss[r] * (1.0f / DM) + EPS);
                v2u* o8 = (v2u*)(O + (size_t)(m0 + hr + r) * DM) + lane;
#pragma unroll
                for (int j = 0; j < 8; ++j) { const f32x4 y = (v[r][j] * rstd) * cs[j] + sh[j];
                    v2u p; p.x = cvt_pk_bf16(y.x, y.y); p.y = cvt_pk_bf16(y.z, y.w); o8[64 * j] = p;
                    { int q = __builtin_amdgcn_cvt_pk_fp8_f32(y.x, y.y, 0, false); q = __builtin_amdgcn_cvt_pk_fp8_f32(y.z, y.w, q, true); *((unsigned*)(O8 + (size_t)(m0 + hr + r) * DM) + lane + 64 * j) = (unsigned)q; } } }
        }
    }
}

template <int W> __device__ __forceinline__ void pool_chunk(const v2u* U4, v2u* P4, int m0, int c4) {
    const bool first = (m0 & (SEQ - 1)) == 0;
    v2u raw[16 + W - 1];
#pragma unroll
    for (int i = 0; i < 16 + W - 1; ++i) { const int tt = i - (W - 1);
        if (tt >= 0 || !first) raw[i] = __builtin_nontemporal_load(U4 + (size_t)(m0 + tt) * 256 + c4); else raw[i] = (v2u){0u, 0u}; }
#define PC_V(i) ((f32x4){pg8::bf_lo(raw[i].x), pg8::bf_hi(raw[i].x), pg8::bf_lo(raw[i].y), pg8::bf_hi(raw[i].y)})
    f32x4 s = {0.f, 0.f, 0.f, 0.f};
#pragma unroll
    for (int i = 0; i < W - 1; ++i) s += PC_V(i);
#pragma unroll
    for (int i = 0; i < 16; ++i) { const f32x4 self = PC_V(W - 1 + i); s += self;
        const float inv = (first && i + 1 < W) ? 1.0f / (float)(i + 1) : 1.0f / (float)W;
        const f32x4 r = s * inv - self; s -= PC_V(i);
        v2u p; p.x = cvt_pk_bf16(r.x, r.y); p.y = cvt_pk_bf16(r.z, r.w);
        P4[(size_t)(m0 + i) * 256 + c4] = p; }
#undef PC_V
}
__device__ __forceinline__ void attn_unit(int unit, const bf16* Q, const bf16* K, const bf16* VT, bf16* O, const float* qw, const float* kw, int lane) {
    const int qb = unit & 63, bh = unit >> 6, b = bh >> 3, h = bh & 7;
    const int r = lane & 31, hh = lane >> 5, q0 = qb * 32;
    const size_t rowbase = (size_t)b * SEQ;
    const float scale = 0.08838834764831845f;
    bf16x8 qf[8];
    { const bf16* qp = Q + (rowbase + q0 + r) * 1024 + h * HD + 8 * hh;
      v4u qraw[8];
#pragma unroll
      for (int s = 0; s < 8; ++s) qraw[s] = *(const v4u*)(qp + 16 * s);
      float ssq = 0.f;
#pragma unroll
      for (int s = 0; s < 8; ++s)
#pragma unroll
          for (int e = 0; e < 4; ++e) { const float a0 = pg8::bf_lo(qraw[s][e]), a1 = pg8::bf_hi(qraw[s][e]); ssq += a0 * a0 + a1 * a1; }
      ssq += __shfl_xor(ssq, 32);
      const float rq = scale / sqrtf(ssq * (1.0f / HD) + EPS);
#pragma unroll
      for (int s = 0; s < 8; ++s) { const int d0 = 16 * s + 8 * hh;
          const f32x4 wa0 = *(const f32x4*)(qw + d0), wa1 = *(const f32x4*)(qw + d0 + 4), wb0 = *(const f32x4*)(kw + d0), wb1 = *(const f32x4*)(kw + d0 + 4);
          const f32x4 c0 = wa0 * wb0 * rq, c1 = wa1 * wb1 * rq;
          v4u w; w.x = cvt_pk_bf16(pg8::bf_lo(qraw[s].x) * c0[0], pg8::bf_hi(qraw[s].x) * c0[1]); w.y = cvt_pk_bf16(pg8::bf_lo(qraw[s].y) * c0[2], pg8::bf_hi(qraw[s].y) * c0[3]);
          w.z = cvt_pk_bf16(pg8::bf_lo(qraw[s].z) * c1[0], pg8::bf_hi(qraw[s].z) * c1[1]); w.w = cvt_pk_bf16(pg8::bf_lo(qraw[s].w) * c1[2], pg8::bf_hi(qraw[s].w) * c1[3]);
          qf[s] = __builtin_bit_cast(bf16x8, w); } }
    f32x16 o[4];
#pragma unroll
    for (int d = 0; d < 4; ++d)
#pragma unroll
        for (int i = 0; i < 16; ++i) o[d][i] = 0.f;
    float R = 0.f;
    const int qpos = q0 + r;
    bf16x8 kf[8];
    const bf16* kfb = K + (size_t)bh * 64 * 8 * 64 * 8 + lane * 8;
    const bf16* vfb = VT + (size_t)bh * 64 * 8 * 64 * 8 + lane * 8;
    { const bf16* kp = kfb + (size_t)qb * 4096;
#pragma unroll
      for (int s = 0; s < 8; ++s) kf[s] = *(const bf16x8*)(kp + 512 * s); }
    for (int kt = qb; ; --kt) {
        const int k0 = kt * 32;
        float ksq = 0.f;
#pragma unroll
        for (int s = 0; s < 8; ++s) { const v4u w = __builtin_bit_cast(v4u, kf[s]);
#pragma unroll
            for (int e = 0; e < 4; ++e) { const float a0 = pg8::bf_lo(w[e]), a1 = pg8::bf_hi(w[e]); ksq += a0 * a0 + a1 * a1; } }
        ksq += __shfl_xor(ksq, 32);
        const float rk = 1.0f / sqrtf(ksq * (1.0f / HD) + EPS);
        f32x16 sa;
#pragma unroll
        for (int i = 0; i < 16; ++i) sa[i] = 0.f;
#pragma unroll
        for (int s = 0; s < 8; ++s) sa = __builtin_amdgcn_mfma_f32_32x32x16_bf16(kf[s], qf[s], sa, 0, 0, 0);
        const bf16* vp = vfb + (size_t)kt * 4096;
        bf16x8 vf[4][2];
#pragma unroll
        for (int d = 0; d < 4; ++d)
#pragma unroll
            for (int s = 0; s < 2; ++s) vf[d][s] = *(const bf16x8*)(vp + (d * 2 + s) * 512);
        { const bf16* kp = kfb + (size_t)(kt > 0 ? kt - 1 : 0) * 4096;
#pragma unroll
          for (int s = 0; s < 8; ++s) kf[s] = *(const bf16x8*)(kp + 512 * s); }
        float l[16], lb[16];
        const int kbase = k0 + 8 * hh;
#pragma unroll
        for (int i = 0; i < 16; ++i) { const float z = sa[i] * __shfl(rk, (((i >> 3) << 4) | (((i >> 2) & 1) << 3) | (i & 3)) + 4 * hh);
            const float sp = fmaxf(z, 0.f) + __logf(1.0f + __expf(-fabsf(z)));
            const bool valid = (kbase + 16 * (i >> 3) + (i & 7)) < qpos;
            l[i] = valid ? -sp : 0.f; lb[i] = valid ? z - sp : -INFINITY; }
        float ra = 0.f, rb = 0.f;
#pragma unroll
        for (int i = 0; i < 8; ++i) { ra += l[i]; rb += l[8 + i]; }
        const float oa = __shfl_xor(ra, 32), ob = __shfl_xor(rb, 32);
        const float T = (ra + oa) + (rb + ob);
        float sufa = R + (hh == 0 ? (oa + (rb + ob)) : (ob + rb));
        float sufb = R + (hh == 0 ? ob : 0.f);
        float p[16];
#pragma unroll
        for (int i = 7; i >= 0; --i) { p[i] = __expf(lb[i] + sufa); sufa += l[i]; p[8 + i] = __expf(lb[8 + i] + sufb); sufb += l[8 + i]; }
        R += T;
        v4u pf[2];
#pragma unroll
        for (int s = 0; s < 2; ++s) { pf[s].x = cvt_pk_bf16(p[8 * s], p[8 * s + 1]); pf[s].y = cvt_pk_bf16(p[8 * s + 2], p[8 * s + 3]); pf[s].z = cvt_pk_bf16(p[8 * s + 4], p[8 * s + 5]); pf[s].w = cvt_pk_bf16(p[8 * s + 6], p[8 * s + 7]); }
#pragma unroll
        for (int d = 0; d < 4; ++d)
#pragma unroll
            for (int s = 0; s < 2; ++s) o[d] = __builtin_amdgcn_mfma_f32_32x32x16_bf16(vf[d][s], __builtin_bit_cast(bf16x8, pf[s]), o[d], 0, 0, 0);
        if (kt == 0 || __all(R < -88.0f)) break;
    }
    bf16* op = O + (rowbase + q0 + r) * 2048 + h * HD + 4 * hh;
#pragma unroll
    for (int d = 0; d < 4; ++d)
#pragma unroll
        for (int i4 = 0; i4 < 4; ++i4) { v2u w; w.x = cvt_pk_bf16(o[d][4 * i4], o[d][4 * i4 + 1]); w.y = cvt_pk_bf16(o[d][4 * i4 + 2], o[d][4 * i4 + 3]); *(v2u*)(op + 32 * d + 8 * i4) = w; }
}

__device__ __forceinline__ void bias2_gemv(const Args& a, int lane, int gw2, int NGW2) {
    const bf16* WT = (const bf16*)(a.ws + WS_WFF1); const float* modp = (const float*)(a.ws + WS_MOD) + 3 * DM; float* B2 = (float*)(a.ws + WS_BIAS2);
    f32x4 sh[4][4][2];
#pragma unroll
    for (int bb = 0; bb < 4; ++bb)
#pragma unroll
        for (int j = 0; j < 4; ++j)
#pragma unroll
            for (int h2 = 0; h2 < 2; ++h2) sh[bb][j][h2] = *(const f32x4*)(modp + (size_t)bb * NMOD + (j * 64 + lane) * 8 + 4 * h2);
    for (int n = gw2; n < DFF; n += NGW2) {
        v4u w[4];
#pragma unroll
        for (int j = 0; j < 4; ++j) w[j] = *(const v4u*)(WT + (size_t)n * DM + (j * 64 + lane) * 8);
        float sb[4] = {0.f, 0.f, 0.f, 0.f};
#pragma unroll
        for (int j = 0; j < 4; ++j) { const f32x4 w0 = {pg8::bf_lo(w[j].x), pg8::bf_hi(w[j].x), pg8::bf_lo(w[j].y), pg8::bf_hi(w[j].y)}, w1 = {pg8::bf_lo(w[j].z), pg8::bf_hi(w[j].z), pg8::bf_lo(w[j].w), pg8::bf_hi(w[j].w)};
#pragma unroll
            for (int bb = 0; bb < 4; ++bb) { const f32x4 p = sh[bb][j][0] * w0 + sh[bb][j][1] * w1; sb[bb] += (p[0] + p[1]) + (p[2] + p[3]); } }
#pragma unroll
        for (int bb = 0; bb < 4; ++bb) sb[bb] = wave_sum(sb[bb]);
        if (lane == 0) { B2[n] = sb[0]; B2[DFF + n] = sb[1]; B2[2 * DFF + n] = sb[2]; B2[3 * DFF + n] = sb[3]; }
    }
}
__global__ void __launch_bounds__(NTHREADS, 2) mega_fwd(Args args) {
    extern __shared__ __attribute__((aligned(16))) unsigned char lds_raw[];
    LAS unsigned char* lds = (LAS unsigned char*)lds_raw;
    const int G = gridDim.x, NGW = G * NWAVES;
    { int t0_ = threadIdx.x; if (t0_ < 64) ((LAS unsigned*)(lds + 131072))[t0_] = 0u; }
    __syncthreads();
    const XcdBarrier bar = xcd_barrier_post((unsigned*)(args.ws + WS_BAR), (volatile LAS unsigned*)(lds + 131072));
#define FRESH_IDS() int tid = threadIdx.x; asm volatile("" : "+v"(tid)); const int lane = tid & 63, wave = __builtin_amdgcn_readfirstlane(tid >> 6), gw = blockIdx.x * NWAVES + wave; (void)lane; (void)gw
    unsigned char* ws = args.ws;
    const float* mod = (const float*)(ws + WS_MOD);
    const int lo = args.ph_lo, hi = args.ph_hi;
#define IN(k) (lo <= (k) && (k) < hi)
#ifndef PROBE_REP
#define PROBE_REP -1
#endif
#define REPS(k) for (int rep_ = 0; rep_ < ((PROBE_REP == (k)) ? 2 : 1); ++rep_, (void)((PROBE_REP == (k) && rep_ < 2) ? (cg::this_grid().sync(), 0) : 0))
#define SEAM(k) do { if (IN(k) && IN((k) + 1)) { xcd_barrier(bar); } } while (0)
    if (lo < 0) cg::this_grid().sync();
    typedef pg8::bf16_t* bp; typedef const pg8::bf16_t* cbp;

    if (IN(0)) REPS(0) { FRESH_IDS(); phase0(args, lds, tid, lane, wave, G, rep_ == 0); }
    SEAM(0);
    if (IN(1)) REPS(1) { FRESH_IDS(); norm_mod_rows(args.in[0], args.in[4], mod, 0, DM, (bf16*)(ws + WS_H), ws + WS_H8, lane, gw, NGW); }
    SEAM(1);
    if (IN(2)) REPS(2) {
        {
            pg8::Gemm g{(cbp)(ws + WS_H), (cbp)(ws + WS_WIN), DM, DM, DM, 0, 1 << 30, 0, 0, (cbp)(ws + WS_WIN) + (size_t)3072 * DM, (cbp)(ws + WS_H)};
            pg8::TwoGemmOrder S; S.init(MTOK, 3072, SBW, MTOK, G, (int)blockIdx.x);
            pg8::EpiP2 E{{(bp)(ws + WS_U), (bp)(ws + WS_Q), (bp)(ws + WS_K), (bp)(ws + WS_SG)}, {(bp)(ws + WS_VT)}};
            pg8::gemm_phase<pg8::EpiP2, pg8::TwoGemmOrder, true, true>(lds, g, S, E);
        }
        {
            pg8::Gemm g{(cbp)(ws + WS_H8), (cbp)(ws + WS_WG8), DM / 2, DM / 2, DM / 2, 0, 1 << 30, 0, 0}; pg8::StaticOrder S; S.init(MTOK, 4096, G, (int)blockIdx.x);
            pg8::EpiGate8 E{(unsigned char*)(ws + WS_SG)};
            pg8::gemm_phase<pg8::EpiGate8, pg8::StaticOrder, true, true, true>(lds, g, S, E);
        }
    }
    SEAM(2);
    if (IN(4)) {
        for (int arep_ = 0; arep_ < (PROBE_REP == 4 ? 2 : 1); ++arep_) { FRESH_IDS();
        for (int u = gw; u < BATCH * NH * 64; u += NGW) attn_unit(u, (const bf16*)(ws + WS_Q), (const bf16*)(ws + WS_K), (const bf16*)(ws + WS_VT), (bf16*)(ws + WS_AM), args.in[6], args.in[7], lane); }
        if ((int)blockIdx.x >= G / 2) { FRESH_IDS(); bias2_gemv(args, lane, ((int)blockIdx.x - G / 2) * NWAVES + wave, (G - G / 2) * NWAVES); }
        {
            FRESH_IDS(); pg8::StaticOrder S; S.init(MTOK, PW, G, (int)blockIdx.x); pg8::Unit u;
            const v2u* U4 = (const v2u*)(ws + WS_U); v2u* P4 = (v2u*)(ws + WS_POOLED);
            for (int i = 0; S.next(i, u); ++i)
                for (int e = 0; e < 2; ++e) { const int idx = tid + NTHREADS * e, m0 = u.pm * 256 + (idx >> 6) * 16, c4 = u.pn * 64 + (idx & 63);
                    if (u.pn == 0) pool_chunk<2>(U4, P4, m0, c4); else if (u.pn == 1) pool_chunk<4>(U4, P4, m0, c4); else if (u.pn == 2) pool_chunk<8>(U4, P4, m0, c4); else pool_chunk<16>(U4, P4, m0, c4); }
            asm volatile("s_waitcnt vmcnt(0)" ::: "memory");
        }
        __syncthreads();
        {
            pg8::Gemm g{(cbp)(ws + WS_POOLED), (cbp)(ws + WS_WPOOL), 256, PW, 256, 256, 1 << 30, 0, 0}; pg8::StaticOrder S; S.init(MTOK, PW, G, (int)blockIdx.x);
            pg8::EpiBf16<2> E{(bp)(ws + WS_AM) + SBW, DM, args.in[9]};
            pg8::gemm_phase<pg8::EpiBf16<2>, pg8::StaticOrder, true, true>(lds, g, S, E);
        }
    }
    SEAM(4);
    if (IN(5)) REPS(5) {
        pg8::Gemm g{(cbp)(ws + WS_AM), (cbp)(ws + WS_WBA), DM, DM, DM, 0, 1 << 30, 0, (SBW / 64)}; pg8::StaticOrder S; S.init(MTOK, DM, G, (int)blockIdx.x);
        pg8::EpiGateMerge E{(const unsigned char*)(ws + WS_SG), (bp)(ws + WS_H)};
        pg8::gemm_phase<pg8::EpiGateMerge, pg8::StaticOrder, true, true>(lds, g, S, E);
    }
    SEAM(5);
    if (IN(6)) REPS(6) {
        pg8::Gemm g{(cbp)(ws + WS_H), (cbp)(ws + WS_WO), DM, DM, DM, 0, 1 << 30, 0, 0}; pg8::StaticOrder S; S.init(MTOK, DM, G, (int)blockIdx.x);
        pg8::EpiResNorm E{args.in[0], (bp)(ws + WS_X1B), mod, args.in[13], (bp)(ws + WS_A2), (float*)(ws + WS_ROWSQ)};
        pg8::gemm_phase<pg8::EpiResNorm, pg8::StaticOrder, true, true>(lds, g, S, E);
    }
    SEAM(6);
    if (IN(8)) REPS(8) {
        pg8::Gemm g{(cbp)(ws + WS_A2), (cbp)(ws + WS_WFF1), DM, DM, DM, 0, 1 << 30, 0, 0}; pg8::StaticOrder S; S.init(MTOK, DFF, G, (int)blockIdx.x);
        pg8::EpiFF1 E{(bp)(ws + WS_F1), (const float*)(ws + WS_ROWSQ), (const float*)(ws + WS_BIAS2)};
        pg8::gemm_phase<pg8::EpiFF1, pg8::StaticOrder, true, true>(lds, g, S, E);
    }
    SEAM(8);
    if (IN(9)) {
        pg8::Gemm g{(cbp)(ws + WS_F1), (cbp)(ws + WS_WFF2), DFF, DFF, DFF, 0, 1 << 30, 0, 0}; pg8::StaticOrder S; S.init(MTOK, DM, G, (int)blockIdx.x);
        pg8::EpiOut E{(cbp)(ws + WS_X1B), args.out, mod + 5 * DM};
        pg8::gemm_phase<pg8::EpiOut, pg8::StaticOrder, true, true>(lds, g, S, E);
    }
#undef IN
#undef SEAM
}

extern "C" void kernel_launch(void* const* d_in, const int* in_sizes, int n_in, void* d_out, int out_size, void* d_ws, size_t ws_size, hipStream_t stream) {
    static int grid = 0;
    if (grid == 0) {
        if (n_in != 16 || out_size != MTOK * DM || ws_size < WS_END) { fprintf(stderr, "kernel_launch: unexpected shapes (n_in %d, out %d, ws %zu)\n", n_in, out_size, ws_size); grid = -1; return; }
        int dev = 0, cus = 0, per_cu = 0;
        if (hipGetDevice(&dev) != hipSuccess || hipDeviceGetAttribute(&cus, hipDeviceAttributeMultiprocessorCount, dev) != hipSuccess) { grid = -1; return; }
        if (hipFuncSetAttribute((const void*)mega_fwd, hipFuncAttributeMaxDynamicSharedMemorySize, LDS_BYTES) != hipSuccess) { fprintf(stderr, "kernel_launch: hipFuncSetAttribute failed\n"); grid = -1; return; }
        if (hipOccupancyMaxActiveBlocksPerMultiprocessor(&per_cu, (const void*)mega_fwd, NTHREADS, LDS_BYTES) != hipSuccess || per_cu < 1) { fprintf(stderr, "kernel_launch: occupancy query says %d\n", per_cu); (void)hipGetLastError(); grid = -1; return; }
        grid = cus;
    }
    if (grid < 0) return;
    (void)hipMemsetAsync((char*)d_ws + WS_MOD, 0, CTL_ZERO_BYTES, stream);
    Args a{};
    for (int i = 0; i < 16; ++i) a.in[i] = (const float*)d_in[i];
    a.out = (float*)d_out; a.ws = (unsigned char*)d_ws;
#if MK_N_LAUNCHES == 1
    a.ph_lo = 0; a.ph_hi = 10;
    void* kargs[] = {&a};
    hipError_t e = hipLaunchCooperativeKernel((const void*)mega_fwd, dim3(grid), dim3(NTHREADS), kargs, LDS_BYTES, stream);
    if (e != hipSuccess) fprintf(stderr, "cooperative launch failed: %s (grid %d)\n", hipGetErrorString(e), grid);
#else
    for (int p = 0; p < 10; ++p) { a.ph_lo = p; a.ph_hi = p + 1; hipLaunchKernelGGL(mega_fwd, dim3(grid), dim3(NTHREADS), LDS_BYTES, stream, a); }
#endif
}
```

```cpp
#include <hip/hip_runtime.h>
#include <hip/hip_cooperative_groups.h>
#include <cstdio>
#include <cstdint>
namespace cg = cooperative_groups;
#ifndef MK_N_LAUNCHES
#define MK_N_LAUNCHES 1
#endif
namespace pg8 {
#define PG8_LAS __attribute__((address_space(3)))
typedef unsigned short bf16_t;
typedef short bf16x8 __attribute__((ext_vector_type(8)));
typedef float f32x4 __attribute__((ext_vector_type(4)));
typedef unsigned u32x4 __attribute__((ext_vector_type(4)));
typedef int i32x4 __attribute__((ext_vector_type(4)));
typedef int i32x8 __attribute__((ext_vector_type(8)));
typedef unsigned u32x2 __attribute__((ext_vector_type(2)));
constexpr int BM = 256, BK = 64, HALF = 128, HTB = HALF * BK * 2  , STAGE_BYTES = 8 * HTB, NXCD = 8, WGM = 8;

__host__ __device__ __forceinline__ int lds_byte(int r, int c) { const int st = (r >> 4) * 2 + (c >> 5), rr = r & 15, cc = c & 31, ob = rr * 64 + cc * 2; return st * 1024 + (ob ^ (((ob >> 9) & 1) << 5)); }
__host__ __device__ __forceinline__ void stage_rc(int b, int& R, int& C) { const int st = b / 1024, sb = b % 1024, swz = sb ^ (((sb >> 9) & 1) << 5); R = (st >> 1) * 16 + swz / 64; C = (st & 1) * 32 + (swz % 64) / 2; }
__host__ __device__ __forceinline__ int perm32(int rho) { const int n = rho >> 4, i = rho & 15; return 8 * (i >> 2) + 4 * n + (i & 3); }

struct Unit { int pm, pn, kind; };
struct Gemm { const bf16_t* A; const bf16_t* Bt; int K, lda, ldb, a_pn_off, gap_at, gap, mid_t; const bf16_t* A2; const bf16_t* Bt2; };

struct StaticOrder {
    int nM, nN, nwg, G, c;
    __host__ __device__ void init(int M, int N, int G_, int c_) { nM = M / BM; nN = N / BM; nwg = nM * nN; G = G_; c = c_; }
    __host__ __device__ bool next(int i, Unit& u) const {
        const long L = (long)i * G + c; if (L >= nwg) return false;
        int wgid = (int)L; { const int q = nwg / NXCD, r = nwg % NXCD, xcd = wgid % NXCD, off = wgid / NXCD; wgid = (xcd < r ? xcd * (q + 1) : r * (q + 1) + (xcd - r) * q) + off; }
        const int nig = WGM * nN, gid = wgid / nig, fm = gid * WGM, gsz = (nM - fm) < WGM ? (nM - fm) : WGM;
        u.pm = fm + ((wgid % nig) % gsz); u.pn = (wgid % nig) / gsz; u.kind = 0; return true;
    }
    __device__ __forceinline__ void a_ready(const Unit&) const {}
    __device__ __forceinline__ void done(const Unit&) const {}
};
struct TwoGemmOrder {
    StaticOrder S0, S1; int G, c;
    __host__ __device__ void init(int M0, int N0, int M1, int N1, int G_, int c_) { S0.init(M0, N0, 1, 0); S1.init(M1, N1, 1, 0); G = G_; c = c_; }
    __host__ __device__ bool next(int i, Unit& u) const { const long L = (long)i * G + c;
        if (L < S0.nwg) return S0.next((int)L, u);
        if (L - S0.nwg < S1.nwg) { const bool ok = S1.next((int)(L - S0.nwg), u); u.kind = 1; return ok; }
        return false; }
    __device__ __forceinline__ void a_ready(const Unit&) const {}
    __device__ __forceinline__ void done(const Unit&) const {}
};


typedef float f32x2 __attribute__((ext_vector_type(2))); typedef __bf16 bf16x2_t __attribute__((ext_vector_type(2)));
__device__ __forceinline__ unsigned cvt_pk_bf16(float lo, float hi) { f32x2 v = {lo, hi}; bf16x2_t b = __builtin_convertvector(v, bf16x2_t); return __builtin_bit_cast(unsigned, b); }
__device__ __forceinline__ u32x4 pack8(f32x4 v0, f32x4 v1) { u32x4 w; w.x = cvt_pk_bf16(v0[0], v0[1]); w.y = cvt_pk_bf16(v0[2], v0[3]); w.z = cvt_pk_bf16(v1[0], v1[1]); w.w = cvt_pk_bf16(v1[2], v1[3]); return w; }
__device__ __forceinline__ float bf_lo(unsigned w) { return __uint_as_float(w << 16); }
__device__ __forceinline__ float bf_hi(unsigned w) { return __uint_as_float(w & 0xffff0000u); }
__device__ __forceinline__ float sigmoidf_(float x) { return __builtin_amdgcn_rcpf(1.0f + __expf(-x)); }

template <int MODE> struct EpiBf16 {
    static constexpr bool PERM = true, AFTER_DRAIN = false, HAS_MID = false;
    bf16_t* O; int ldc; const float* colscale;
    __device__ __forceinline__ void operator()(const f32x4 (&acc)[2][2][4][2], const Unit& u, int wr, int wc, int fr, int fq) const {
        const int row0 = u.pm * BM + wr * 64 + fr, col0 = u.pn * BM + wc * 32 + 8 * fq;
        f32x4 cs[2][2];
        if (MODE == 2) {
#pragma unroll
            for (int bj = 0; bj < 2; ++bj)
#pragma unroll
                for (int n = 0; n < 2; ++n) cs[bj][n] = *(const f32x4*)(colscale + col0 + bj * HALF + 4 * n);
        }
#pragma unroll
        for (int ai = 0; ai < 2; ++ai)
#pragma unroll
            for (int m = 0; m < 4; ++m) { bf16_t* rowp = O + (size_t)(row0 + ai * HALF + m * 16) * ldc + col0;
#pragma unroll
                for (int bj = 0; bj < 2; ++bj) { f32x4 v0 = acc[ai][bj][m][0], v1 = acc[ai][bj][m][1];
                    if (MODE == 1) {
#pragma unroll
                        for (int e = 0; e < 4; ++e) { const float a = fmaxf(v0[e], 0.f), b = fmaxf(v1[e], 0.f); v0[e] = a * a; v1[e] = b * b; } }
                    if (MODE == 2) { v0 = v0 * cs[bj][0]; v1 = v1 * cs[bj][1]; }
                    *(u32x4*)(rowp + bj * HALF) = pack8(v0, v1); } }
    }
};
struct EpiVF {
    static constexpr bool PERM = true, AFTER_DRAIN = false, HAS_MID = false;
    bf16_t* VF;
    __device__ __forceinline__ void operator()(const f32x4 (&acc)[2][2][4][2], const Unit& u, int wr, int wc, int fr, int fq) const {
        const int row0 = u.pm * BM + wr * 64 + fr, col0 = u.pn * BM + wc * 32 + 8 * fq;
#pragma unroll
        for (int ai = 0; ai < 2; ++ai)
#pragma unroll
            for (int m = 0; m < 4; ++m) { const int row = row0 + ai * HALF + m * 16, h = row >> 7, db = (row >> 5) & 3, r = row & 31;
#pragma unroll
                for (int bj = 0; bj < 2; ++bj) { const int c = col0 + bj * HALF, b = c >> 11, t = c & 2047, tile = t >> 5, s = (t >> 4) & 1, hh = (t >> 3) & 1;
                    const size_t off = ((((((size_t)(b * 8 + h) * 64 + tile) * 4 + db) * 2 + s) * 2 + hh) * 32 + r) * 8;
                    *(u32x4*)(VF + off) = pack8(acc[ai][bj][m][0], acc[ai][bj][m][1]); } }
    }
};
struct EpiP1 {
    static constexpr bool PERM = true, AFTER_DRAIN = false, HAS_MID = false;
    bf16_t* U; bf16_t* Q; bf16_t* KF; bf16_t* SG;
    __device__ __forceinline__ void operator()(const f32x4 (&acc)[2][2][4][2], const Unit& u, int wr, int wc, int fr, int fq) const {
        const int pn = u.pn + (u.pn >= 12 ? 4 : 0);
        const int row0 = u.pm * BM + wr * 64 + fr, cl = wc * 32 + 8 * fq;
        if (pn < 8) {
            bf16_t* base = pn < 4 ? U : Q; const int colt = (pn & 3) * 256;
#pragma unroll
            for (int ai = 0; ai < 2; ++ai)
#pragma unroll
                for (int m = 0; m < 4; ++m) { bf16_t* rowp = base + (size_t)(row0 + ai * HALF + m * 16) * 1024 + colt + cl;
#pragma unroll
                    for (int bj = 0; bj < 2; ++bj) *(u32x4*)(rowp + bj * HALF) = pack8(acc[ai][bj][m][0], acc[ai][bj][m][1]); }
        } else if (pn < 12) {
            const int sd = cl >> 4, hh = (cl >> 3) & 1;
#pragma unroll
            for (int ai = 0; ai < 2; ++ai)
#pragma unroll
                for (int m = 0; m < 4; ++m) { const int row = row0 + ai * HALF + m * 16, t = row & 2047, kk = t & 31, slot = (kk & ~12) | ((kk & 4) << 1) | ((kk & 8) >> 1);
#pragma unroll
                    for (int bj = 0; bj < 2; ++bj) { const int h = (pn - 8) * 2 + bj;
                        const size_t off = (((((size_t)((row >> 11) * 8 + h) * 64 + (t >> 5)) * 8 + sd) * 2 + hh) * 32 + slot) * 8;
                        *(u32x4*)(KF + off) = pack8(acc[ai][bj][m][0], acc[ai][bj][m][1]); } }
        } else {
            const int colt = (pn - 16) * 256;
            unsigned char* SG8 = (unsigned char*)SG;
#pragma unroll
            for (int ai = 0; ai < 2; ++ai)
#pragma unroll
                for (int m = 0; m < 4; ++m) { unsigned char* rowp = SG8 + (size_t)(row0 + ai * HALF + m * 16) * 4096 + colt + cl;
#pragma unroll
                    for (int bj = 0; bj < 2; ++bj) { const f32x4 v0 = acc[ai][bj][m][0], v1 = acc[ai][bj][m][1]; unsigned q[8];
#pragma unroll
                        for (int e = 0; e < 4; ++e) { q[e] = (unsigned)fminf(fmaxf(sigmoidf_(v0[e]) * 255.0f + 0.5f, 1.0f), 255.0f); q[4 + e] = (unsigned)fminf(fmaxf(sigmoidf_(v1[e]) * 255.0f + 0.5f, 1.0f), 255.0f); }
                        u32x2 w; w.x = q[0] | (q[1] << 8) | (q[2] << 16) | (q[3] << 24); w.y = q[4] | (q[5] << 8) | (q[6] << 16) | (q[7] << 24);
                        *(u32x2*)(rowp + bj * HALF) = w; } }
        }
    }
};
struct EpiGate8 {
    static constexpr bool PERM = true, AFTER_DRAIN = false, HAS_MID = false;
    unsigned char* SG8;
    __device__ __forceinline__ void operator()(const f32x4 (&acc)[2][2][4][2], const Unit& u, int wr, int wc, int fr, int fq) const {
        int t_ = threadIdx.x; asm volatile("" : "+v"(t_));
        const int l_ = t_ & 63, w_ = t_ >> 6; fr = l_ & 15; fq = l_ >> 4; wr = w_ >> 2; wc = w_ & 3;
        const int row0 = u.pm * BM + wr * 64 + fr, col0 = u.pn * BM + wc * 32 + 8 * fq;
#pragma unroll
        for (int ai = 0; ai < 2; ++ai)
#pragma unroll
            for (int m = 0; m < 4; ++m) { unsigned char* rowp = SG8 + (size_t)(row0 + ai * HALF + m * 16) * 4096 + col0;
#pragma unroll
                for (int bj = 0; bj < 2; ++bj) { const f32x4 v0 = acc[ai][bj][m][0] * 0.015625f, v1 = acc[ai][bj][m][1] * 0.015625f; unsigned q[8];
#pragma unroll
                    for (int e = 0; e < 4; ++e) { q[e] = (unsigned)fminf(fmaxf(sigmoidf_(v0[e]) * 255.0f + 0.5f, 1.0f), 255.0f); q[4 + e] = (unsigned)fminf(fmaxf(sigmoidf_(v1[e]) * 255.0f + 0.5f, 1.0f), 255.0f); }
                    u32x2 w; w.x = q[0] | (q[1] << 8) | (q[2] << 16) | (q[3] << 24); w.y = q[4] | (q[5] << 8) | (q[6] << 16) | (q[7] << 24);
                    *(u32x2*)(rowp + bj * HALF) = w; } }
    }
};
struct EpiP2 {
    static constexpr bool PERM = true, AFTER_DRAIN = false, HAS_MID = false;
    EpiP1 a; EpiVF b;
    __device__ __forceinline__ void operator()(const f32x4 (&acc)[2][2][4][2], const Unit& u, int wr, int wc, int fr, int fq) const { if (u.kind) b(acc, u, wr, wc, fr, fq); else a(acc, u, wr, wc, fr, fq); }
};
struct EpiGateMerge {
    static constexpr bool PERM = true, AFTER_DRAIN = false, HAS_MID = true;
    const unsigned char* SG8; bf16_t* O;
#define UB(w, i) ((float)(((w) >> (8 * (i))) & 0xffu))
    __device__ __forceinline__ void mid(f32x4 (&acc)[2][2][4][2], const Unit& u, int wr, int wc, int fr, int fq) const {
        const int row0 = u.pm * BM + wr * 64 + fr, col0 = u.pn * BM + wc * 32 + 8 * fq;
        const unsigned char* sp0 = SG8 + (size_t)row0 * 4096 + col0; asm volatile("" : "+v"(sp0));
#pragma unroll
        for (int ai = 0; ai < 2; ++ai)
#pragma unroll
            for (int m = 0; m < 4; ++m) { const unsigned char* sp = sp0 + (size_t)(ai * HALF + m * 16) * 4096;
#pragma unroll
                for (int bj = 0; bj < 2; ++bj) { const u32x2 ga = __builtin_nontemporal_load((const u32x2*)(sp + bj * HALF)), gb = __builtin_nontemporal_load((const u32x2*)(sp + 2048 + bj * HALF));
                    f32x4 r0, r1;
                    r0[0] = UB(gb.x, 0) * __builtin_amdgcn_rcpf(UB(ga.x, 0)); r0[1] = UB(gb.x, 1) * __builtin_amdgcn_rcpf(UB(ga.x, 1));
                    r0[2] = UB(gb.x, 2) * __builtin_amdgcn_rcpf(UB(ga.x, 2)); r0[3] = UB(gb.x, 3) * __builtin_amdgcn_rcpf(UB(ga.x, 3));
                    r1[0] = UB(gb.y, 0) * __builtin_amdgcn_rcpf(UB(ga.y, 0)); r1[1] = UB(gb.y, 1) * __builtin_amdgcn_rcpf(UB(ga.y, 1));
                    r1[2] = UB(gb.y, 2) * __builtin_amdgcn_rcpf(UB(ga.y, 2)); r1[3] = UB(gb.y, 3) * __builtin_amdgcn_rcpf(UB(ga.y, 3));
                    acc[ai][bj][m][0] *= r0; acc[ai][bj][m][1] *= r1; }
                if (m == 3) asm volatile("" ::: "memory"); }
    }
    __device__ __forceinline__ void operator()(const f32x4 (&acc)[2][2][4][2], const Unit& u, int wr, int wc, int fr, int fq) const {
        const int row0 = u.pm * BM + wr * 64 + fr, col0 = u.pn * BM + wc * 32 + 8 * fq;
        const float k = 1.0f / 255.0f;
#pragma unroll
        for (int ai = 0; ai < 2; ++ai)
#pragma unroll
            for (int m = 0; m < 4; ++m) { const size_t row = (size_t)(row0 + ai * HALF + m * 16);
#pragma unroll
                for (int bj = 0; bj < 2; ++bj) { const u32x2 g = __builtin_nontemporal_load((const u32x2*)(SG8 + row * 4096 + col0 + bj * HALF));
                    const f32x4 g0 = {UB(g.x, 0) * k, UB(g.x, 1) * k, UB(g.x, 2) * k, UB(g.x, 3) * k}, g1 = {UB(g.y, 0) * k, UB(g.y, 1) * k, UB(g.y, 2) * k, UB(g.y, 3) * k};
                    *(u32x4*)(O + row * 2048 + col0 + bj * HALF) = pack8(acc[ai][bj][m][0] * g0, acc[ai][bj][m][1] * g1); } }
    }
#undef UB
};
struct EpiResNorm {
    static constexpr bool PERM = true, AFTER_DRAIN = false, HAS_MID = false;
    const float* base; bf16_t* X1B; const float* mod; const float* nw; bf16_t* A2; float* rowsq;
    __device__ __forceinline__ void operator()(const f32x4 (&acc)[2][2][4][2], const Unit& u, int wr, int wc, int fr, int fq) const {
        const int row0 = u.pm * BM + wr * 64 + fr, col0 = u.pn * BM + wc * 32 + 8 * fq;
        const float* mb = mod + (size_t)(u.pm >> 3) * 12288 + col0;
        f32x4 gv[2][2], cs[2][2];
#pragma unroll
        for (int bj = 0; bj < 2; ++bj)
#pragma unroll
            for (int n = 0; n < 2; ++n) { gv[bj][n] = *(const f32x4*)(mb + 4096 + bj * HALF + 4 * n);
                cs[bj][n] = *(const f32x4*)(nw + col0 + bj * HALF + 4 * n) * (*(const f32x4*)(mb + 8192 + bj * HALF + 4 * n) + 1.0f); }
#pragma unroll
        for (int ai = 0; ai < 2; ++ai)
#pragma unroll
            for (int mp = 0; mp < 4; mp += 2) {
                f32x4 bs[2][2][2];
#pragma unroll
                for (int m2 = 0; m2 < 2; ++m2) { const size_t off = (size_t)(row0 + ai * HALF + (mp + m2) * 16) * 2048 + col0;
#pragma unroll
                    for (int bj = 0; bj < 2; ++bj)
#pragma unroll
                        for (int n = 0; n < 2; ++n) bs[m2][bj][n] = __builtin_nontemporal_load((const f32x4*)(base + off + bj * HALF + 4 * n)); }
                asm volatile("" ::: "memory");
#pragma unroll
                for (int m2 = 0; m2 < 2; ++m2) { const int row = row0 + ai * HALF + (mp + m2) * 16; const size_t off = (size_t)row * 2048 + col0; float q = 0.f;
#pragma unroll
                    for (int bj = 0; bj < 2; ++bj) { const f32x4 x0 = bs[m2][bj][0] + gv[bj][0] * acc[ai][bj][mp + m2][0], x1 = bs[m2][bj][1] + gv[bj][1] * acc[ai][bj][mp + m2][1];
                        *(u32x4*)(X1B + off + bj * HALF) = pack8(x0, x1);
                        q += ((x0[0] * x0[0] + x0[1] * x0[1]) + (x0[2] * x0[2] + x0[3] * x0[3])) + ((x1[0] * x1[0] + x1[1] * x1[1]) + (x1[2] * x1[2] + x1[3] * x1[3]));
                        *(u32x4*)(A2 + off + bj * HALF) = pack8(x0 * cs[bj][0], x1 * cs[bj][1]); }
                    q += __shfl_xor(q, 16); q += __shfl_xor(q, 32);
                    if (fq == 0) atomicAdd(rowsq + row, q); }
                asm volatile("" ::: "memory"); }
    }
};
struct EpiFF1 {
    static constexpr bool PERM = true, AFTER_DRAIN = false, HAS_MID = false;
    bf16_t* O; const float* rowsq; const float* bias2;
    __device__ __forceinline__ void operator()(const f32x4 (&acc)[2][2][4][2], const Unit& u, int wr, int wc, int fr, int fq) const {
        const int row0 = u.pm * BM + wr * 64 + fr, col0 = u.pn * BM + wc * 32 + 8 * fq;
        const float* bp = bias2 + (size_t)(u.pm >> 3) * 8192 + col0;
        float rs[2][4];
#pragma unroll
        for (int ai = 0; ai < 2; ++ai)
#pragma unroll
            for (int m = 0; m < 4; ++m) rs[ai][m] = rowsq[row0 + ai * HALF + m * 16];
        f32x4 bv[2][2];
#pragma unroll
        for (int bj = 0; bj < 2; ++bj)
#pragma unroll
            for (int n = 0; n < 2; ++n) bv[bj][n] = *(const f32x4*)(bp + bj * HALF + 4 * n);
#pragma unroll
        for (int ai = 0; ai < 2; ++ai)
#pragma unroll
            for (int m = 0; m < 4; ++m) { const float rstd = 1.0f / sqrtf(rs[ai][m] * (1.0f / 2048.0f) + 1e-6f);
                bf16_t* rowp = O + (size_t)(row0 + ai * HALF + m * 16) * 8192 + col0;
#pragma unroll
                for (int bj = 0; bj < 2; ++bj) { f32x4 v0 = acc[ai][bj][m][0] * rstd + bv[bj][0], v1 = acc[ai][bj][m][1] * rstd + bv[bj][1];
#pragma unroll
                    for (int e = 0; e < 4; ++e) { const float a = fmaxf(v0[e], 0.f), b = fmaxf(v1[e], 0.f); v0[e] = a * a; v1[e] = b * b; }
                    *(u32x4*)(rowp + bj * HALF) = pack8(v0, v1); } }
    }
};
struct EpiOut {
    static constexpr bool PERM = true, AFTER_DRAIN = false, HAS_MID = false;
    const bf16_t* X1B; float* out; const float* gate;
    __device__ __forceinline__ void operator()(const f32x4 (&acc)[2][2][4][2], const Unit& u, int wr, int wc, int fr, int fq) const {
        const int row0 = u.pm * BM + wr * 64 + fr, col0 = u.pn * BM + wc * 32 + 8 * fq;
        const float* gp = gate + (size_t)(u.pm >> 3) * 12288 + col0;
        f32x4 gv[2][2];
#pragma unroll
        for (int bj = 0; bj < 2; ++bj)
#pragma unroll
            for (int n = 0; n < 2; ++n) gv[bj][n] = *(const f32x4*)(gp + bj * HALF + 4 * n);
#pragma unroll
        for (int ai = 0; ai < 2; ++ai) {
            u32x4 xb[4][2];
#pragma unroll
            for (int m = 0; m < 4; ++m)
#pragma unroll
                for (int bj = 0; bj < 2; ++bj) xb[m][bj] = __builtin_nontemporal_load((const u32x4*)(X1B + (size_t)(row0 + ai * HALF + m * 16) * 2048 + col0 + bj * HALF));
#pragma unroll
            for (int m = 0; m < 4; ++m) { float* op = out + (size_t)(row0 + ai * HALF + m * 16) * 2048 + col0;
#pragma unroll
                for (int bj = 0; bj < 2; ++bj) { const u32x4 g = xb[m][bj];
                    const f32x4 x0 = {bf_lo(g.x), bf_hi(g.x), bf_lo(g.y), bf_hi(g.y)}, x1 = {bf_lo(g.z), bf_hi(g.z), bf_lo(g.w), bf_hi(g.w)};
                    *(f32x4*)(op + bj * HALF) = x0 + gv[bj][0] * acc[ai][bj][m][0]; *(f32x4*)(op + bj * HALF + 4) = x1 + gv[bj][1] * acc[ai][bj][m][1]; } }
        }
    }
};
struct EpiRes {
    static constexpr bool PERM = false, AFTER_DRAIN = false, HAS_MID = false;
    const float* base; float* out; const float* gate;
    __device__ __forceinline__ void operator()(const f32x4 (&acc)[2][2][4][2], const Unit& u, int wr, int wc, int fr, int fq) const {
        const int row0 = u.pm * BM + wr * 64 + fr, col0 = u.pn * BM + wc * 32 + 4 * fq;
        const float* gp = gate + (size_t)(u.pm >> 3) * 12288 + col0;
        f32x4 gv[2][2];
#pragma unroll
        for (int bj = 0; bj < 2; ++bj)
#pragma unroll
            for (int n = 0; n < 2; ++n) gv[bj][n] = *(const f32x4*)(gp + bj * HALF + n * 16);
#pragma unroll
        for (int ai = 0; ai < 2; ++ai)
#pragma unroll
            for (int m = 0; m < 4; ++m) { const size_t off = (size_t)(row0 + ai * HALF + m * 16) * 2048 + col0;
#pragma unroll
                for (int bj = 0; bj < 2; ++bj)
#pragma unroll
                    for (int n = 0; n < 2; ++n) { const f32x4 bs = __builtin_nontemporal_load((const f32x4*)(base + off + bj * HALF + n * 16)); *(f32x4*)(out + off + bj * HALF + n * 16) = bs + gv[bj][n] * acc[ai][bj][m][n]; } }
    }
};
template <class Epi, class Sched, bool ALIGN_EPI = false, bool SP2 = false, bool FP8 = false>
__device__ __forceinline__ void gemm_phase(PG8_LAS unsigned char* lds, const Gemm g, const Sched& S, const Epi& E) {
    int tid_ = threadIdx.x; asm volatile("" : "+v"(tid_));
    const int tid = tid_, wid = __builtin_amdgcn_readfirstlane(tid >> 6), lane = tid & 63, wr = wid >> 2, wc = wid & 3, fr = lane & 15, fq = lane >> 4;
    const int K = g.K, nt = K / BK;
    unsigned voffA[1], voffB[1];
    { int R, C; stage_rc(tid * 16, R, C); const int Rb = Epi::PERM ? ((R & ~31) + perm32(R & 31)) : R;
      voffA[0] = (unsigned)(R * g.lda + C) * 2u; voffB[0] = (unsigned)(Rb * g.ldb + C) * 2u; }
    const size_t voffA_step = (size_t)64 * g.lda * 2, voffB_step = (size_t)64 * g.ldb * 2;
    const size_t kstep = (size_t)(BK * 2);
    const size_t hstepA = (size_t)HALF * g.lda * 2, hstepB = (size_t)HALF * g.ldb * 2;
    const size_t tstepA = 2 * hstepA, tstepB = 2 * hstepB;
#define PG8_APTR(u) ((u).kind ? (const char*)g.A2 + (size_t)(u).pm * tstepA : (const char*)g.A + (size_t)(u).pm * tstepA + (size_t)(u).pn * (size_t)g.a_pn_off * 2)
#define PG8_BPTR(u) ((u).kind ? (const char*)g.Bt2 + (size_t)(u).pn * tstepB : (const char*)g.Bt + (size_t)((u).pn + ((u).pn >= g.gap_at ? g.gap : 0)) * tstepB)
    const unsigned ldsw = (unsigned)wid * 1024u;
    const int aoff = lds_byte(wr * 64 + fr, fq * 8), boff = lds_byte(wc * 32 + fr, fq * 8);
#define PG8_SA(b, h) (((b) * 2 + (h)) * HTB)
#define PG8_SB(b, h) ((4 + (b) * 2 + (h)) * HTB)
#define PG8_STAGE(bufoff, gbase, voff) do { _Pragma("unroll") for (int _i = 0; _i < 2; ++_i) \
        __builtin_amdgcn_global_load_lds((const unsigned*)((const char*)(gbase) + (size_t)_i * voff##_step + (voff)[0]), (PG8_LAS unsigned*)(lds + (bufoff) + ldsw + _i * 8192), 16, 0, 0); } while (0)
#define PG8_LDA(dst, b, h) do { if constexpr (FP8) { _Pragma("unroll") for (int m = 0; m < 4; ++m) dst##8[m] = __builtin_shufflevector(*(const PG8_LAS i32x4*)(lds + PG8_SA(b, h) + aoff + m * 2048), *(const PG8_LAS i32x4*)(lds + PG8_SA(b, h) + aoff + m * 2048 + 1024), 0, 1, 2, 3, 4, 5, 6, 7); } \
    else { _Pragma("unroll") for (int m = 0; m < 4; ++m) _Pragma("unroll") for (int k = 0; k < 2; ++k) dst[m][k] = *(const PG8_LAS bf16x8*)(lds + PG8_SA(b, h) + aoff + m * 2048 + k * 1024); } } while (0)
#define PG8_LDB(dst, b, h) do { if constexpr (FP8) { _Pragma("unroll") for (int n = 0; n < 2; ++n) dst##8[n] = __builtin_shufflevector(*(const PG8_LAS i32x4*)(lds + PG8_SB(b, h) + boff + n * 2048), *(const PG8_LAS i32x4*)(lds + PG8_SB(b, h) + boff + n * 2048 + 1024), 0, 1, 2, 3, 4, 5, 6, 7); } \
    else { _Pragma("unroll") for (int n = 0; n < 2; ++n) _Pragma("unroll") for (int k = 0; k < 2; ++k) dst[n][k] = *(const PG8_LAS bf16x8*)(lds + PG8_SB(b, h) + boff + n * 2048 + k * 1024); } } while (0)
#define PG8_MMA(ai, bj, At, Bt) do { __builtin_amdgcn_s_setprio(1); if constexpr (FP8) { _Pragma("unroll") for (int m = 0; m < 4; ++m) _Pragma("unroll") for (int n = 0; n < 2; ++n) \
        acc[ai][bj][m][n] = __builtin_amdgcn_mfma_scale_f32_16x16x128_f8f6f4(Bt##8[n], At##8[m], acc[ai][bj][m][n], 0, 0, 0, 0x7f7f7f7f, 0, 0x7f7f7f7f); } else { \
        _Pragma("unroll") for (int m = 0; m < 4; ++m) _Pragma("unroll") for (int n = 0; n < 2; ++n) _Pragma("unroll") for (int k = 0; k < 2; ++k) \
        acc[ai][bj][m][n] = __builtin_amdgcn_mfma_f32_16x16x32_bf16(Bt[n][k], At[m][k], acc[ai][bj][m][n], 0, 0, 0); } __builtin_amdgcn_s_setprio(0); } while (0)
#define PG8_WAIT_V(n) asm volatile("s_waitcnt vmcnt(" #n ")" ::: "memory")
#define PG8_WAIT_L(n) asm volatile("s_waitcnt lgkmcnt(" #n ")" ::: "memory")
#define PG8_BAR __builtin_amdgcn_s_barrier()
#define PG8_SCHED __builtin_amdgcn_sched_barrier(0)
    Unit cur, nxt; int ui = 0;
    if (!S.next(0, cur)) return;
    f32x4 acc[2][2][4][2];
#pragma unroll
    for (int a = 0; a < 2; ++a)
#pragma unroll
        for (int b = 0; b < 2; ++b)
#pragma unroll
            for (int m = 0; m < 4; ++m)
#pragma unroll
                for (int n = 0; n < 2; ++n) acc[a][b][m][n] = (f32x4){0.f, 0.f, 0.f, 0.f};
    bf16x8 At[4][2], B0[2][2], B1[2][2]; i32x8 At8[4], B08[2], B18[2];
    const char* cA = PG8_APTR(cur); const char* cB = PG8_BPTR(cur);
    S.a_ready(cur);
    if constexpr (SP2) {
        PG8_STAGE(PG8_SB(0, 0), cB, voffB); PG8_STAGE(PG8_SB(0, 1), cB + hstepB, voffB); PG8_STAGE(PG8_SA(0, 0), cA, voffA); PG8_STAGE(PG8_SA(0, 1), cA + hstepA, voffA);
        if (wr == 1) PG8_BAR;
        PG8_WAIT_V(2); PG8_BAR;
        PG8_STAGE(PG8_SB(1, 0), cB + kstep, voffB); PG8_STAGE(PG8_SA(1, 0), cA + kstep, voffA); PG8_STAGE(PG8_SB(1, 1), cB + hstepB + kstep, voffB);
        PG8_WAIT_V(6); PG8_BAR;
    } else {
        PG8_STAGE(PG8_SB(0, 0), cB, voffB); PG8_STAGE(PG8_SA(0, 0), cA, voffA); PG8_STAGE(PG8_SB(0, 1), cB + hstepB, voffB); PG8_STAGE(PG8_SA(0, 1), cA + hstepA, voffA);
        if (wr == 1) PG8_BAR;
        PG8_WAIT_V(4); PG8_BAR;
        PG8_STAGE(PG8_SB(1, 0), cB + kstep, voffB); PG8_STAGE(PG8_SA(1, 0), cA + kstep, voffA); PG8_STAGE(PG8_SB(1, 1), cB + hstepB + kstep, voffB);
        PG8_WAIT_V(6); PG8_BAR;
    }
    for (;;) {
        const bool has_next = S.next(ui + 1, nxt);
        const char* nA = has_next ? PG8_APTR(nxt) : cA; const char* nB = has_next ? PG8_BPTR(nxt) : cB;
        for (int t = 0; t < nt; t += 2) {
            if constexpr (Epi::HAS_MID) { if (t == g.mid_t) E.mid(acc, cur, wr, wc, fr, fq); }
            const bool last = (t == nt - 2);
            const char* a1 = cA + (size_t)(t + 1) * kstep;
            const char* a2 = last ? nA : cA + (size_t)(t + 2) * kstep; const char* b2 = last ? nB : cB + (size_t)(t + 2) * kstep;
            const char* a3 = a2 + kstep; const char* b3 = b2 + kstep;
            if (last && has_next) S.a_ready(nxt);
            if constexpr (SP2) {
            PG8_LDB(B0, 0, 0); PG8_LDB(B1, 0, 1); PG8_SCHED; PG8_LDA(At, 0, 0); PG8_STAGE(PG8_SA(1, 1), a1 + hstepA, voffA);
            PG8_WAIT_V(8); PG8_WAIT_L(0); PG8_BAR; PG8_MMA(0, 0, At, B0); PG8_MMA(0, 1, At, B1); PG8_BAR; PG8_SCHED;
            PG8_LDA(At, 0, 1); PG8_STAGE(PG8_SB(0, 0), b2, voffB); PG8_STAGE(PG8_SB(0, 1), b2 + hstepB, voffB); PG8_STAGE(PG8_SA(0, 0), a2, voffA);
            PG8_WAIT_V(8); PG8_WAIT_L(0); PG8_BAR; PG8_MMA(1, 0, At, B0); PG8_MMA(1, 1, At, B1); PG8_BAR; PG8_SCHED;
            PG8_LDB(B0, 1, 0); PG8_LDB(B1, 1, 1); PG8_SCHED; PG8_LDA(At, 1, 0); PG8_STAGE(PG8_SA(0, 1), a2 + hstepA, voffA);
            PG8_WAIT_V(8); PG8_WAIT_L(0); PG8_BAR; PG8_MMA(0, 0, At, B0); PG8_MMA(0, 1, At, B1); PG8_BAR; PG8_SCHED;
            PG8_LDA(At, 1, 1); PG8_STAGE(PG8_SB(1, 0), b3, voffB); PG8_STAGE(PG8_SB(1, 1), b3 + hstepB, voffB); PG8_STAGE(PG8_SA(1, 0), a3, voffA);
            PG8_WAIT_V(8); PG8_WAIT_L(0); PG8_BAR; PG8_MMA(1, 0, At, B0); PG8_MMA(1, 1, At, B1); PG8_BAR; PG8_SCHED;
            } else {
            PG8_LDB(B0, 0, 0); PG8_SCHED; PG8_LDA(At, 0, 0); PG8_STAGE(PG8_SA(1, 1), a1 + hstepA, voffA);
            PG8_WAIT_L(8); PG8_BAR; PG8_WAIT_L(0); PG8_MMA(0, 0, At, B0); PG8_BAR; PG8_SCHED;
            PG8_LDB(B1, 0, 1); PG8_STAGE(PG8_SB(0, 0), b2, voffB);
            PG8_BAR; PG8_WAIT_L(0); PG8_MMA(0, 1, At, B1); PG8_BAR;
            PG8_LDA(At, 0, 1); PG8_STAGE(PG8_SA(0, 0), a2, voffA);
            PG8_BAR; PG8_WAIT_L(0); PG8_MMA(1, 0, At, B0); PG8_BAR; PG8_SCHED;
            PG8_STAGE(PG8_SB(0, 1), b2 + hstepB, voffB);
            PG8_WAIT_V(6); PG8_BAR; PG8_MMA(1, 1, At, B1); PG8_BAR;
            PG8_LDB(B0, 1, 0); PG8_SCHED; PG8_LDA(At, 1, 0); PG8_STAGE(PG8_SA(0, 1), a2 + hstepA, voffA);
            PG8_WAIT_L(8); PG8_BAR; PG8_WAIT_L(0); PG8_MMA(0, 0, At, B0); PG8_BAR; PG8_SCHED;
            PG8_LDB(B1, 1, 1); PG8_STAGE(PG8_SB(1, 0), b3, voffB);
            PG8_BAR; PG8_WAIT_L(0); PG8_MMA(0, 1, At, B1); PG8_BAR;
            PG8_LDA(At, 1, 1); PG8_STAGE(PG8_SA(1, 0), a3, voffA);
            PG8_BAR; PG8_WAIT_L(0); PG8_MMA(1, 0, At, B0); PG8_BAR; PG8_SCHED;
            PG8_STAGE(PG8_SB(1, 1), b3 + hstepB, voffB);
            PG8_WAIT_V(6); PG8_BAR; PG8_MMA(1, 1, At, B1); PG8_BAR;
            }
        }
        if constexpr (ALIGN_EPI) { if (wr == 0) PG8_BAR; }
        if constexpr (!Epi::AFTER_DRAIN) { E(acc, cur, wr, wc, fr, fq); S.done(cur); }
        if (!has_next) break;
#pragma unroll
        for (int a = 0; a < 2; ++a)
#pragma unroll
            for (int b = 0; b < 2; ++b)
#pragma unroll
                for (int m = 0; m < 4; ++m)
#pragma unroll
                    for (int n = 0; n < 2; ++n) acc[a][b][m][n] = (f32x4){0.f, 0.f, 0.f, 0.f};
        cur = nxt; cA = nA; cB = nB; ++ui;
        if constexpr (ALIGN_EPI) { if (wr == 1) PG8_BAR; }
    }
    PG8_WAIT_V(0);
    if constexpr (!ALIGN_EPI) { if (wr == 0) PG8_BAR; }
    PG8_BAR;
    if constexpr (Epi::AFTER_DRAIN) { E.fused(acc, cur, wr, wc, fr, fq, lds, wid, lane); S.done(cur); }
#undef PG8_APTR
#undef PG8_BPTR
#undef PG8_SA
#undef PG8_SB
#undef PG8_STAGE
#undef PG8_LDA
#undef PG8_LDB
#undef PG8_MMA
#undef PG8_WAIT_V
#undef PG8_WAIT_L
#undef PG8_BAR
#undef PG8_SCHED
}
}

constexpr int NWAVES = 8, NTHREADS = NWAVES * 64;
constexpr int BATCH = 4, SEQ = 2048, DM = 2048, MTOK = BATCH * SEQ;
constexpr int PW = 1024, SBW = 1024, NH = 8, HD = 128, INW = 8192, DFF = 8192, NMOD = 6 * DM;
constexpr float EPS = 1e-6f;
constexpr size_t MiB = 1u << 20;
constexpr size_t WS_MOD = 0;
constexpr size_t CTL_ZERO_BYTES = 256 * 1024;
constexpr size_t WS_QUEUE = 196 * 1024;
constexpr size_t WS_BAR = 200 * 1024;
constexpr size_t WS_ROWSQ = 216 * 1024;
constexpr size_t WS_BIAS2 = 113 * MiB + 512 * 1024;
constexpr size_t WS_X1B = 306 * MiB;
constexpr size_t WS_A2 = 274 * MiB;
constexpr size_t WS_WIN = 1 * MiB, WS_WFF1 = 33 * MiB, WS_WFF2 = 65 * MiB, WS_WO = 97 * MiB, WS_WBA = 105 * MiB, WS_WPOOL = 113 * MiB;
constexpr size_t WS_H = 114 * MiB;
constexpr size_t WS_R = 146 * MiB;
constexpr size_t WS_U = WS_R, WS_Q = WS_R + 32 * MiB, WS_K = WS_R + 48 * MiB, WS_VT = WS_R + 64 * MiB, WS_POOLED = WS_R + 80 * MiB, WS_AM = WS_R + 96 * MiB;
constexpr size_t WS_F1 = WS_R;
constexpr size_t WS_SG = 274 * MiB, WS_H8 = 338 * MiB, WS_END = 354 * MiB;
constexpr size_t WS_WG8 = WS_WIN + 16 * MiB;
constexpr int LDS_BYTES = 131072 + 1024;

#define LAS __attribute__((address_space(3)))
typedef unsigned short bf16;
typedef unsigned v4u __attribute__((ext_vector_type(4)));
typedef unsigned v2u __attribute__((ext_vector_type(2)));
typedef float f32x4 __attribute__((ext_vector_type(4)));
typedef float f32x16 __attribute__((ext_vector_type(16)));
typedef short bf16x8 __attribute__((ext_vector_type(8)));
#define LDS_WAIT() asm volatile("s_waitcnt lgkmcnt(0)" ::: "memory")
using pg8::cvt_pk_bf16;

__device__ __forceinline__ float wave_sum(float v) {
#pragma unroll
    for (int o = 1; o < 64; o <<= 1) v += __shfl_xor(v, o);
    return v;
}
__device__ __forceinline__ void p0_transpose_item(const float* W, int K, int N, bf16* WT, int ldt, LAS unsigned short* T, int item, int lane) {
    const int nblk = N / 64, kb = item / nblk, nb = item % nblk, k0 = 64 * kb, n0 = 64 * nb;
    const int row = lane >> 4, n4 = lane & 15;
    f32x4 v[16];
#pragma unroll
    for (int i = 0; i < 16; ++i) v[i] = __builtin_nontemporal_load((const f32x4*)(W + (size_t)(k0 + 4 * i + row) * N + n0 + 4 * n4));
#pragma unroll
    for (int i = 0; i < 16; ++i) { const int k = 4 * i + row; const unsigned p01 = cvt_pk_bf16(v[i].x, v[i].y), p23 = cvt_pk_bf16(v[i].z, v[i].w);
        T[(4 * n4 + 0) * 66 + k] = (unsigned short)p01; T[(4 * n4 + 1) * 66 + k] = (unsigned short)(p01 >> 16);
        T[(4 * n4 + 2) * 66 + k] = (unsigned short)p23; T[(4 * n4 + 3) * 66 + k] = (unsigned short)(p23 >> 16); }
    LDS_WAIT(); asm volatile("" ::: "memory");
    const int kc = lane & 7;
#pragma unroll
    for (int j = 0; j < 8; ++j) { const int n = (lane >> 3) + 8 * j; const LAS unsigned* tp = (const LAS unsigned*)(T + n * 66 + 8 * kc);
        v4u o; o.x = tp[0]; o.y = tp[1]; o.z = tp[2]; o.w = tp[3];
        *(v4u*)(WT + (size_t)(n0 + n) * ldt + k0 + 8 * kc) = o; }
    LDS_WAIT(); asm volatile("" ::: "memory");
}


#define XB_TMO      128
#define XB_XCNT(j)  (256  + 64 * (j))
#define XB_XSUB(j)  (1280 + 64 * (j))
#define XB_XGEN(j)  (2304 + 64 * (j))
#define XB_TOP      3328
#define XB_TOPGEN   3392
#define XCD_BAR_WORDS 3456
#define XB_SPIN_CAP (1u << 18)

__device__ __forceinline__ unsigned xb_ld(unsigned* p)              { return __hip_atomic_load(p, __ATOMIC_RELAXED, __HIP_MEMORY_SCOPE_AGENT); }
__device__ __forceinline__ unsigned xb_add(unsigned* p, unsigned v) { return __hip_atomic_fetch_add(p, v, __ATOMIC_RELAXED, __HIP_MEMORY_SCOPE_AGENT); }
__device__ __forceinline__ unsigned xb_xcc_id() { return (unsigned)__builtin_amdgcn_s_getreg((3 << 11) | 20) & 0xFu; }
#define XB_SPIN(cond, bar) do { unsigned _sp = 0; while (cond) { __builtin_amdgcn_s_sleep(1); \
    if ((++_sp & 255u) == 0u) { if (xb_ld(&(bar)[XB_TMO])) break; if (_sp > XB_SPIN_CAP) { atomicAdd(&(bar)[XB_TMO], 1u); break; } } } } while (0)

struct XcdBarrier {
    unsigned* bar; unsigned x;
    volatile LAS unsigned* st;
};

__device__ __forceinline__ XcdBarrier xcd_barrier_post(unsigned* bar, volatile LAS unsigned* st) {
    XcdBarrier b; b.bar = bar; b.x = xb_xcc_id(); b.st = st;
    if (threadIdx.x == 0) (void)xb_add(&bar[XB_XCNT(b.x)], 1u);
    return b;
}
__device__ __forceinline__ void xcd_barrier_complete(unsigned* bar, unsigned x, unsigned& nloc, unsigned& nx) {
    const unsigned G = gridDim.x * gridDim.y * gridDim.z;
    unsigned sum, cnt, mine, sp = 0u;
    for (;;) {
        sum = 0u; cnt = 0u; mine = 0u;
#pragma unroll
        for (unsigned j = 0; j < 16; ++j) { const unsigned c = xb_ld(&bar[XB_XCNT(j)]); sum += c; cnt += (c > 0u) ? 1u : 0u; mine = (j == x) ? c : mine; }
        if (sum == G) break;
        __builtin_amdgcn_s_sleep(1);
        if ((++sp & 255u) == 0u) { if (xb_ld(&bar[XB_TMO])) break; if (sp > XB_SPIN_CAP) { atomicAdd(&bar[XB_TMO], 1u); break; } }
    }
    nloc = mine > 0u ? mine : 1u; nx = cnt > 0u ? cnt : 1u;
}

__device__ __forceinline__ void xcd_barrier(const XcdBarrier& b) {
    asm volatile("s_waitcnt vmcnt(0)" ::: "memory");
    __syncthreads();
    if (threadIdx.x == 0) {
        unsigned* bar = b.bar;
        __builtin_amdgcn_s_waitcnt(0);
        unsigned nloc = b.st[0], nx = b.st[1];
        if (nloc == 0u) { xcd_barrier_complete(bar, b.x, nloc, nx); b.st[0] = nloc; b.st[1] = nx; }
        const unsigned old = xb_add(&bar[XB_XSUB(b.x)], 1u);
        const unsigned gen = old / nloc;
        if (old + 1u == (gen + 1u) * nloc) {
            __builtin_amdgcn_fence(__ATOMIC_RELEASE, "agent");
            asm volatile("s_waitcnt vmcnt(0)" ::: "memory");
            const unsigned og = xb_add(&bar[XB_TOP], 1u);
            const unsigned tg = og / nx;
            if (og + 1u == (tg + 1u) * nx) xb_add(&bar[XB_TOPGEN], 1u);
            else XB_SPIN(xb_ld(&bar[XB_TOPGEN]) == tg, bar);
            __builtin_amdgcn_fence(__ATOMIC_ACQUIRE, "agent");
            xb_add(&bar[XB_XGEN(b.x)], 1u);
            asm volatile("s_waitcnt vmcnt(0)" ::: "memory");
        } else {
            XB_SPIN(xb_ld(&bar[XB_XGEN(b.x)]) == gen, bar);
            __builtin_amdgcn_fence(__ATOMIC_ACQUIRE, "agent");
            asm volatile("s_waitcnt vmcnt(0)" ::: "memory");
        }
    }
    __syncthreads();
}

struct Args { const float* in[16]; float* out; unsigned char* ws; int ph_lo, ph_hi; };

__device__ __forceinline__ void p0_transpose_item_f8(const float* W, int N, unsigned char* W8, int ld8, int ncol0, LAS unsigned short* T, int item, int lane) {
    const int nblk = N / 64, kb = item / nblk, nb = item % nblk, k0 = 64 * kb, n0 = 64 * nb;
    const int row = lane >> 4, n4 = lane & 15;
    f32x4 v[16];
#pragma unroll
    for (int i = 0; i < 16; ++i) v[i] = __builtin_nontemporal_load((const f32x4*)(W + (size_t)(k0 + 4 * i + row) * N + n0 + 4 * n4));
#pragma unroll
    for (int i = 0; i < 16; ++i) { const int k = 4 * i + row; const unsigned p01 = cvt_pk_bf16(v[i].x, v[i].y), p23 = cvt_pk_bf16(v[i].z, v[i].w);
        T[(4 * n4 + 0) * 66 + k] = (unsigned short)p01; T[(4 * n4 + 1) * 66 + k] = (unsigned short)(p01 >> 16);
        T[(4 * n4 + 2) * 66 + k] = (unsigned short)p23; T[(4 * n4 + 3) * 66 + k] = (unsigned short)(p23 >> 16); }
    LDS_WAIT(); asm volatile("" ::: "memory");
    const int pc = lane & 3;
#pragma unroll
    for (int j = 0; j < 4; ++j) { const int n = (lane >> 2) + 16 * j; const LAS unsigned* tp = (const LAS unsigned*)(T + n * 66 + 16 * pc);
        v4u o;
#pragma unroll
        for (int d = 0; d < 4; ++d) { const unsigned w0 = tp[2 * d], w1 = tp[2 * d + 1];
            int p = __builtin_amdgcn_cvt_pk_fp8_f32(pg8::bf_lo(w0) * 64.0f, pg8::bf_hi(w0) * 64.0f, 0, false);
            p = __builtin_amdgcn_cvt_pk_fp8_f32(pg8::bf_lo(w1) * 64.0f, pg8::bf_hi(w1) * 64.0f, p, true); o[d] = (unsigned)p; }
        *(v4u*)(W8 + (size_t)(n0 - ncol0 + n) * ld8 + k0 + 16 * pc) = o; }
    LDS_WAIT(); asm volatile("" ::: "memory");
}

__device__ __forceinline__ void phase0(const Args& a, LAS unsigned char* lds, int tid, int lane, int wave, int G, bool do_atomics) {
    const float* c = a.in[1]; const float* w_ada = a.in[2]; const float* b_ada = a.in[3];
    float* mod = (float*)(a.ws + WS_MOD);
    unsigned* qhead = (unsigned*)(a.ws + WS_QUEUE) + (do_atomics ? 0 : 64);
    LAS float* sc = (LAS float*)lds;
    LAS float* red = (LAS float*)(lds + 8192);
    LAS unsigned short* T = (LAS unsigned short*)(lds + 8192 + wave * 8448);
    volatile LAS unsigned* slot = (volatile LAS unsigned*)(lds + 131072 + 512);
    constexpr int I_IN = (DM / 64) * (INW / 64), I_F1 = (DM / 64) * (DFF / 64), I_F2 = (DFF / 64) * (DM / 64), I_O = (DM / 64) * (DM / 64), I_A = (PW / 64) * (DM / 64), I_B = (SBW / 64) * (DM / 64), I_P = 4 * 4 * 4;
    constexpr int NITEMS = I_IN + I_F1 + I_F2 + I_O + I_A + I_B + I_P, NROUNDS = 192 + NITEMS / 8;
    static_assert(NITEMS % 8 == 0, "transpose items come in rounds of 8 (one per wave)");
    for (;;) {
        __syncthreads();
        if (tid == 0) slot[0] = __hip_atomic_fetch_add(qhead, 1u, __ATOMIC_RELAXED, __HIP_MEMORY_SCOPE_AGENT);
        __syncthreads();
        const int rd = (int)slot[0];
        if (rd >= NROUNDS) break;
        if (rd < 192) {
            const int cc = rd % 48, kc = rd / 48;
            for (int idx = tid; idx < 2048; idx += NTHREADS) { const float cv = c[(idx >> 9) * DM + kc * 512 + (idx & 511)]; sc[idx] = cv / (1.0f + __expf(-cv)); }
            __syncthreads();
            f32x4 acc[4];
#pragma unroll
            for (int b = 0; b < 4; ++b) acc[b] = (f32x4){0.f, 0.f, 0.f, 0.f};
            const float* wp = w_ada + (size_t)(kc * 512 + wave * 64) * NMOD + cc * 256 + lane * 4;
#pragma unroll 8
            for (int i = 0; i < 64; ++i) { const f32x4 w4 = __builtin_nontemporal_load((const f32x4*)(wp + (size_t)i * NMOD));
#pragma unroll
                for (int b = 0; b < 4; ++b) acc[b] += sc[b * 512 + wave * 64 + i] * w4; }
#pragma unroll
            for (int b = 0; b < 4; ++b) *(LAS f32x4*)(red + (wave * 4 + b) * 256 + lane * 4) = acc[b];
            __syncthreads();
#pragma unroll
            for (int e = 0; e < 2; ++e) { const int idx = tid + 512 * e, b = idx >> 8, col = idx & 255; float s = 0.f;
#pragma unroll
                for (int w = 0; w < 8; ++w) s += red[(w * 4 + b) * 256 + col];
                if (kc == 0) s += b_ada[cc * 256 + col];
                if (do_atomics) atomicAdd(mod + b * NMOD + cc * 256 + col, s); }
        } else {
            int r = (rd - 192) * 8 + wave;
            if (r < I_IN) { if ((r % (INW / 64)) >= 64) p0_transpose_item_f8(a.in[5], INW, a.ws + WS_WG8, DM, 4096, T, r, lane);
                            else p0_transpose_item(a.in[5], DM, INW, (bf16*)(a.ws + WS_WIN), DM, T, r, lane); continue; } r -= I_IN;
            if (r < I_F1) { p0_transpose_item(a.in[14], DM, DFF, (bf16*)(a.ws + WS_WFF1), DM, T, r, lane); continue; } r -= I_F1;
            if (r < I_F2) { p0_transpose_item(a.in[15], DFF, DM, (bf16*)(a.ws + WS_WFF2), DFF, T, r, lane); continue; } r -= I_F2;
            if (r < I_O) { p0_transpose_item(a.in[12], DM, DM, (bf16*)(a.ws + WS_WO), DM, T, r, lane); continue; } r -= I_O;
            if (r < I_A) { p0_transpose_item(a.in[10], PW, DM, (bf16*)(a.ws + WS_WBA) + SBW, DM, T, r, lane); continue; } r -= I_A;
            if (r < I_B) { p0_transpose_item(a.in[11], SBW, DM, (bf16*)(a.ws + WS_WBA), DM, T, r, lane); continue; } r -= I_B;
            { const int g = r >> 4; p0_transpose_item(a.in[8] + (size_t)g * 65536, 256, 256, (bf16*)(a.ws + WS_WPOOL) + (size_t)g * 65536, 256, T, r & 15, lane); }
        }
    }
}

__device__ __forceinline__ void norm_mod_rows(const float* X, const float* nw, const float* mod, int shift_off, int scale_off, bf16* O, unsigned char* O8, int lane, int gw, int NGW) {
    for (int m0 = gw * 4; m0 < MTOK; m0 += NGW * 4) {
        const float* mb = mod + (size_t)(m0 >> 11) * NMOD;
        f32x4 cs[8], sh[8];
#pragma unroll
        for (int j = 0; j < 8; ++j) { const int col = 4 * (lane + 64 * j); cs[j] = *(const f32x4*)(nw + col) * (*(const f32x4*)(mb + scale_off + col) + 1.0f); sh[j] = *(const f32x4*)(mb + shift_off + col); }
#pragma unroll 1
        for (int hr = 0; hr < 4; hr += 2) {
            f32x4 v[2][8];
#pragma unroll
            for (int r = 0; r < 2; ++r)
#pragma unroll
                for (int j = 0; j < 8; ++j) v[r][j] = __builtin_nontemporal_load((const f32x4*)(X + (size_t)(m0 + hr + r) * DM) + lane + 64 * j);
            float ss[2];
#pragma unroll
            for (int r = 0; r < 2; ++r) { float s = 0.f;
#pragma unroll
                for (int j = 0; j < 8; ++j) s += (v[r][j].x * v[r][j].x + v[r][j].y * v[r][j].y) + (v[r][j].z * v[r][j].z + v[r][j].w * v[r][j].w);
                ss[r] = s; }
#pragma unroll
            for (int o = 1; o < 64; o <<= 1) { ss[0] += __shfl_xor(ss[0], o); ss[1] += __shfl_xor(ss[1], o); }
#pragma unroll
            for (int r = 0; r < 2; ++r) { const float rstd = 1.0f / sqrtf(ss[r] * (1.0f / DM) + EPS);
                v2u* o8 = (v2u*)(O + (size_t)(m0 + hr + r) * DM) + lane;
#pragma unroll
                for (int j = 0; j < 8; ++j) { const f32x4 y = (v[r][j] * rstd) * cs[j] + sh[j];
                    v2u p; p.x = cvt_pk_bf16(y.x, y.y); p.y = cvt_pk_bf16(y.z, y.w); o8[64 * j] = p;
                    { int q = __builtin_amdgcn_cvt_pk_fp8_f32(y.x, y.y, 0, false); q = __builtin_amdgcn_cvt_pk_fp8_f32(y.z, y.w, q, true); *((unsigned*)(O8 + (size_t)(m0 + hr + r) * DM) + lane + 64 * j) = (unsigned)q; } } }
        }
    }
}

template <int W> __device__ __forceinline__ void pool_chunk(const v2u* U4, v2u* P4, int m0, int c4) {
    const bool first = (m0 & (SEQ - 1)) == 0;
    v2u raw[16 + W - 1];
#pragma unroll
    for (int i = 0; i < 16 + W - 1; ++i) { const int tt = i - (W - 1);
        if (tt >= 0 || !first) raw[i] = __builtin_nontemporal_load(U4 + (size_t)(m0 + tt) * 256 + c4); else raw[i] = (v2u){0u, 0u}; }
#define PC_V(i) ((f32x4){pg8::bf_lo(raw[i].x), pg8::bf_hi(raw[i].x), pg8::bf_lo(raw[i].y), pg8::bf_hi(raw[i].y)})
    f32x4 s = {0.f, 0.f, 0.f, 0.f};
#pragma unroll
    for (int i = 0; i < W - 1; ++i) s += PC_V(i);
#pragma unroll
    for (int i = 0; i < 16; ++i) { const f32x4 self = PC_V(W - 1 + i); s += self;
        const float inv = (first && i + 1 < W) ? 1.0f / (float)(i + 1) : 1.0f / (float)W;
        const f32x4 r = s * inv - self; s -= PC_V(i);
        v2u p; p.x = cvt_pk_bf16(r.x, r.y); p.y = cvt_pk_bf16(r.z, r.w);
        P4[(size_t)(m0 + i) * 256 + c4] = p; }
#undef PC_V
}
__device__ __forceinline__ void attn_unit(int unit, const bf16* Q, const bf16* K, const bf16* VT, bf16* O, const float* qw, const float* kw, int lane) {
    const int qb = unit & 63, bh = unit >> 6, b = bh >> 3, h = bh & 7;
    const int r = lane & 31, hh = lane >> 5, q0 = qb * 32;
    const size_t rowbase = (size_t)b * SEQ;
    const float scale = 0.08838834764831845f;
    bf16x8 qf[8];
    { const bf16* qp = Q + (rowbase + q0 + r) * 1024 + h * HD + 8 * hh;
      v4u qraw[8];
#pragma unroll
      for (int s = 0; s < 8; ++s) qraw[s] = *(const v4u*)(qp + 16 * s);
      float ssq = 0.f;
#pragma unroll
      for (int s = 0; s < 8; ++s)
#pragma unroll
          for (int e = 0; e < 4; ++e) { const float a0 = pg8::bf_lo(qraw[s][e]), a1 = pg8::bf_hi(qraw[s][e]); ssq += a0 * a0 + a1 * a1; }
      ssq += __shfl_xor(ssq, 32);
      const float rq = scale / sqrtf(ssq * (1.0f / HD) + EPS);
#pragma unroll
      for (int s = 0; s < 8; ++s) { const int d0 = 16 * s + 8 * hh;
          const f32x4 wa0 = *(const f32x4*)(qw + d0), wa1 = *(const f32x4*)(qw + d0 + 4), wb0 = *(const f32x4*)(kw + d0), wb1 = *(const f32x4*)(kw + d0 + 4);
          const f32x4 c0 = wa0 * wb0 * rq, c1 = wa1 * wb1 * rq;
          v4u w; w.x = cvt_pk_bf16(pg8::bf_lo(qraw[s].x) * c0[0], pg8::bf_hi(qraw[s].x) * c0[1]); w.y = cvt_pk_bf16(pg8::bf_lo(qraw[s].y) * c0[2], pg8::bf_hi(qraw[s].y) * c0[3]);
          w.z = cvt_pk_bf16(pg8::bf_lo(qraw[s].z) * c1[0], pg8::bf_hi(qraw[s].z) * c1[1]); w.w = cvt_pk_bf16(pg8::bf_lo(qraw[s].w) * c1[2], pg8::bf_hi(qraw[s].w) * c1[3]);
          qf[s] = __builtin_bit_cast(bf16x8, w); } }
    f32x16 o[4];
#pragma unroll
    for (int d = 0; d < 4; ++d)
#pragma unroll
        for (int i = 0; i < 16; ++i) o[d][i] = 0.f;
    float R = 0.f;
    const int qpos = q0 + r;
    bf16x8 kf[8];
    const bf16* kfb = K + (size_t)bh * 64 * 8 * 64 * 8 + lane * 8;
    const bf16* vfb = VT + (size_t)bh * 64 * 8 * 64 * 8 + lane * 8;
    { const bf16* kp = kfb + (size_t)qb * 4096;
#pragma unroll
      for (int s = 0; s < 8; ++s) kf[s] = *(const bf16x8*)(kp + 512 * s); }
    for (int kt = qb; ; --kt) {
        const int k0 = kt * 32;
        float ksq = 0.f;
#pragma unroll
        for (int s = 0; s < 8; ++s) { const v4u w = __builtin_bit_cast(v4u, kf[s]);
#pragma unroll
            for (int e = 0; e < 4; ++e) { const float a0 = pg8::bf_lo(w[e]), a1 = pg8::bf_hi(w[e]); ksq += a0 * a0 + a1 * a1; } }
        ksq += __shfl_xor(ksq, 32);
        const float rk = 1.0f / sqrtf(ksq * (1.0f / HD) + EPS);
        f32x16 sa;
#pragma unroll
        for (int i = 0; i < 16; ++i) sa[i] = 0.f;
#pragma unroll
        for (int s = 0; s < 8; ++s) sa = __builtin_amdgcn_mfma_f32_32x32x16_bf16(kf[s], qf[s], sa, 0, 0, 0);
        const bf16* vp = vfb + (size_t)kt * 4096;
        bf16x8 vf[4][2];
#pragma unroll
        for (int d = 0; d < 4; ++d)
#pragma unroll
            for (int s = 0; s < 2; ++s) vf[d][s] = *(const bf16x8*)(vp + (d * 2 + s) * 512);
        { const bf16* kp = kfb + (size_t)(kt > 0 ? kt - 1 : 0) * 4096;
#pragma unroll
          for (int s = 0; s < 8; ++s) kf[s] = *(const bf16x8*)(kp + 512 * s); }
        float l[16], lb[16];
        const int kbase = k0 + 8 * hh;
#pragma unroll
        for (int i = 0; i < 16; ++i) { const float z = sa[i] * __shfl(rk, (((i >> 3) << 4) | (((i >> 2) & 1) << 3) | (i & 3)) + 4 * hh);
            const float sp = fmaxf(z, 0.f) + __logf(1.0f + __expf(-fabsf(z)));
            const bool valid = (kbase + 16 * (i >> 3) + (i & 7)) < qpos;
            l[i] = valid ? -sp : 0.f; lb[i] = valid ? z - sp : -INFINITY; }
        float ra = 0.f, rb = 0.f;
#pragma unroll
        for (int i = 0; i < 8; ++i) { ra += l[i]; rb += l[8 + i]; }
        const float oa = __shfl_xor(ra, 32), ob = __shfl_xor(rb, 32);
        const float T = (ra + oa) + (rb + ob);
        float sufa = R + (hh == 0 ? (oa + (rb + ob)) : (ob + rb));
        float sufb = R + (hh == 0 ? ob : 0.f);
        float p[16];
#pragma unroll
        for (int i = 7; i >= 0; --i) { p[i] = __expf(lb[i] + sufa); sufa += l[i]; p[8 + i] = __expf(lb[8 + i] + sufb); sufb += l[8 + i]; }
        R += T;
        v4u pf[2];
#pragma unroll
        for (int s = 0; s < 2; ++s) { pf[s].x = cvt_pk_bf16(p[8 * s], p[8 * s + 1]); pf[s].y = cvt_pk_bf16(p[8 * s + 2], p[8 * s + 3]); pf[s].z = cvt_pk_bf16(p[8 * s + 4], p[8 * s + 5]); pf[s].w = cvt_pk_bf16(p[8 * s + 6], p[8 * s + 7]); }
#pragma unroll
        for (int d = 0; d < 4; ++d)
#pragma unroll
            for (int s = 0; s < 2; ++s) o[d] = __builtin_amdgcn_mfma_f32_32x32x16_bf16(vf[d][s], __builtin_bit_cast(bf16x8, pf[s]), o[d], 0, 0, 0);
        if (kt == 0 || __all(R < -88.0f)) break;
    }
    bf16* op = O + (rowbase + q0 + r) * 2048 + h * HD + 4 * hh;
#pragma unroll
    for (int d = 0; d < 4; ++d)
#pragma unroll
        for (int i4 = 0; i4 < 4; ++i4) { v2u w; w.x = cvt_pk_bf16(o[d][4 * i4], o[d][4 * i4 + 1]); w.y = cvt_pk_bf16(o[d][4 * i4 + 2], o[d][4 * i4 + 3]); *(v2u*)(op + 32 * d + 8 * i4) = w; }
}

__device__ __forceinline__ void bias2_gemv(const Args& a, int lane, int gw2, int NGW2) {
    const bf16* WT = (const bf16*)(a.ws + WS_WFF1); const float* modp = (const float*)(a.ws + WS_MOD) + 3 * DM; float* B2 = (float*)(a.ws + WS_BIAS2);
    f32x4 sh[4][4][2];
#pragma unroll
    for (int bb = 0; bb < 4; ++bb)
#pragma unroll
        for (int j = 0; j < 4; ++j)
#pragma unroll
            for (int h2 = 0; h2 < 2; ++h2) sh[bb][j][h2] = *(const f32x4*)(modp + (size_t)bb * NMOD + (j * 64 + lane) * 8 + 4 * h2);
    for (int n = gw2; n < DFF; n += NGW2) {
        v4u w[4];
#pragma unroll
        for (int j = 0; j < 4; ++j) w[j] = *(const v4u*)(WT + (size_t)n * DM + (j * 64 + lane) * 8);
        float sb[4] = {0.f, 0.f, 0.f, 0.f};
#pragma unroll
        for (int j = 0; j < 4; ++j) { const f32x4 w0 = {pg8::bf_lo(w[j].x), pg8::bf_hi(w[j].x), pg8::bf_lo(w[j].y), pg8::bf_hi(w[j].y)}, w1 = {pg8::bf_lo(w[j].z), pg8::bf_hi(w[j].z), pg8::bf_lo(w[j].w), pg8::bf_hi(w[j].w)};
#pragma unroll
            for (int bb = 0; bb < 4; ++bb) { const f32x4 p = sh[bb][j][0] * w0 + sh[bb][j][1] * w1; sb[bb] += (p[0] + p[1]) + (p[2] + p[3]); } }
#pragma unroll
        for (int bb = 0; bb < 4; ++bb) sb[bb] = wave_sum(sb[bb]);
        if (lane == 0) { B2[n] = sb[0]; B2[DFF + n] = sb[1]; B2[2 * DFF + n] = sb[2]; B2[3 * DFF + n] = sb[3]; }
    }
}
__global__ void __launch_bounds__(NTHREADS, 2) mega_fwd(Args args) {
    extern __shared__ __attribute__((aligned(16))) unsigned char lds_raw[];
    LAS unsigned char* lds = (LAS unsigned char*)lds_raw;
    const int G = gridDim.x, NGW = G * NWAVES;
    { int t0_ = threadIdx.x; if (t0_ < 64) ((LAS unsigned*)(lds + 131072))[t0_] = 0u; }
    __syncthreads();
    const XcdBarrier bar = xcd_barrier_post((unsigned*)(args.ws + WS_BAR), (volatile LAS unsigned*)(lds + 131072));
#define FRESH_IDS() int tid = threadIdx.x; asm volatile("" : "+v"(tid)); const int lane = tid & 63, wave = __builtin_amdgcn_readfirstlane(tid >> 6), gw = blockIdx.x * NWAVES + wave; (void)lane; (void)gw
    unsigned char* ws = args.ws;
    const float* mod = (const float*)(ws + WS_MOD);
    const int lo = args.ph_lo, hi = args.ph_hi;
#define IN(k) (lo <= (k) && (k) < hi)
#ifndef PROBE_REP
#define PROBE_REP -1
#endif
#define REPS(k) for (int rep_ = 0; rep_ < ((PROBE_REP == (k)) ? 2 : 1); ++rep_, (void)((PROBE_REP == (k) && rep_ < 2) ? (cg::this_grid().sync(), 0) : 0))
#define SEAM(k) do { if (IN(k) && IN((k) + 1)) { xcd_barrier(bar); } } while (0)
    if (lo < 0) cg::this_grid().sync();
    typedef pg8::bf16_t* bp; typedef const pg8::bf16_t* cbp;

    if (IN(0)) REPS(0) { FRESH_IDS(); phase0(args, lds, tid, lane, wave, G, rep_ == 0); }
    SEAM(0);
    if (IN(1)) REPS(1) { FRESH_IDS(); norm_mod_rows(args.in[0], args.in[4], mod, 0, DM, (bf16*)(ws + WS_H), ws + WS_H8, lane, gw, NGW); }
    SEAM(1);
    if (IN(2)) REPS(2) {
        {
            pg8::Gemm g{(cbp)(ws + WS_H), (cbp)(ws + WS_WIN), DM, DM, DM, 0, 1 << 30, 0, 0, (cbp)(ws + WS_WIN) + (size_t)3072 * DM, (cbp)(ws + WS_H)};
            pg8::TwoGemmOrder S; S.init(MTOK, 3072, SBW, MTOK, G, (int)blockIdx.x);
            pg8::EpiP2 E{{(bp)(ws + WS_U), (bp)(ws + WS_Q), (bp)(ws + WS_K), (bp)(ws + WS_SG)}, {(bp)(ws + WS_VT)}};
            pg8::gemm_phase<pg8::EpiP2, pg8::TwoGemmOrder, true, true>(lds, g, S, E);
        }
        {
            pg8::Gemm g{(cbp)(ws + WS_H8), (cbp)(ws + WS_WG8), DM / 2, DM / 2, DM / 2, 0, 1 << 30, 0, 0}; pg8::StaticOrder S; S.init(MTOK, 4096, G, (int)blockIdx.x);
            pg8::EpiGate8 E{(unsigned char*)(ws + WS_SG)};
            pg8::gemm_phase<pg8::EpiGate8, pg8::StaticOrder, true, true, true>(lds, g, S, E);
        }
    }
    SEAM(2);
    if (IN(4)) {
        for (int arep_ = 0; arep_ < (PROBE_REP == 4 ? 2 : 1); ++arep_) { FRESH_IDS();
        for (int u = gw; u < BATCH * NH * 64; u += NGW) attn_unit(u, (const bf16*)(ws + WS_Q), (const bf16*)(ws + WS_K), (const bf16*)(ws + WS_VT), (bf16*)(ws + WS_AM), args.in[6], args.in[7], lane); }
        if ((int)blockIdx.x >= G / 2) { FRESH_IDS(); bias2_gemv(args, lane, ((int)blockIdx.x - G / 2) * NWAVES + wave, (G - G / 2) * NWAVES); }
        {
            FRESH_IDS(); pg8::StaticOrder S; S.init(MTOK, PW, G, (int)blockIdx.x); pg8::Unit u;
            const v2u* U4 = (const v2u*)(ws + WS_U); v2u* P4 = (v2u*)(ws + WS_POOLED);
            for (int i = 0; S.next(i, u); ++i)
                for (int e = 0; e < 2; ++e) { const int idx = tid + NTHREADS * e, m0 = u.pm * 256 + (idx >> 6) * 16, c4 = u.pn * 64 + (idx & 63);
                    if (u.pn == 0) pool_chunk<2>(U4, P4, m0, c4); else if (u.pn == 1) pool_chunk<4>(U4, P4, m0, c4); else if (u.pn == 2) pool_chunk<8>(U4, P4, m0, c4); else pool_chunk<16>(U4, P4, m0, c4); }
            asm volatile("s_waitcnt vmcnt(0)" ::: "memory");
        }
        __syncthreads();
        {
            pg8::Gemm g{(cbp)(ws + WS_POOLED), (cbp)(ws + WS_WPOOL), 256, PW, 256, 256, 1 << 30, 0, 0}; pg8::StaticOrder S; S.init(MTOK, PW, G, (int)blockIdx.x);
            pg8::EpiBf16<2> E{(bp)(ws + WS_AM) + SBW, DM, args.in[9]};
            pg8::gemm_phase<pg8::EpiBf16<2>, pg8::StaticOrder, true, true>(lds, g, S, E);
        }
    }
    SEAM(4);
    if (IN(5)) REPS(5) {
        pg8::Gemm g{(cbp)(ws + WS_AM), (cbp)(ws + WS_WBA), DM, DM, DM, 0, 1 << 30, 0, (SBW / 64)}; pg8::StaticOrder S; S.init(MTOK, DM, G, (int)blockIdx.x);
        pg8::EpiGateMerge E{(const unsigned char*)(ws + WS_SG), (bp)(ws + WS_H)};
        pg8::gemm_phase<pg8::EpiGateMerge, pg8::StaticOrder, true, true>(lds, g, S, E);
    }
    SEAM(5);
    if (IN(6)) REPS(6) {
        pg8::Gemm g{(cbp)(ws + WS_H), (cbp)(ws + WS_WO), DM, DM, DM, 0, 1 << 30, 0, 0}; pg8::StaticOrder S; S.init(MTOK, DM, G, (int)blockIdx.x);
        pg8::EpiResNorm E{args.in[0], (bp)(ws + WS_X1B), mod, args.in[13], (bp)(ws + WS_A2), (float*)(ws + WS_ROWSQ)};
        pg8::gemm_phase<pg8::EpiResNorm, pg8::StaticOrder, true, true>(lds, g, S, E);
    }
    SEAM(6);
    if (IN(8)) REPS(8) {
        pg8::Gemm g{(cbp)(ws + WS_A2), (cbp)(ws + WS_WFF1), DM, DM, DM, 0, 1 << 30, 0, 0}; pg8::StaticOrder S; S.init(MTOK, DFF, G, (int)blockIdx.x);
        pg8::EpiFF1 E{(bp)(ws + WS_F1), (const float*)(ws + WS_ROWSQ), (const float*)(ws + WS_BIAS2)};
        pg8::gemm_phase<pg8::EpiFF1, pg8::StaticOrder, true, true>(lds, g, S, E);
    }
    SEAM(8);
    if (IN(9)) {
        pg8::Gemm g{(cbp)(ws + WS_F1), (cbp)(ws + WS_WFF2), DFF, DFF, DFF, 0, 1 << 30, 0, 0}; pg8::StaticOrder S; S.init(MTOK, DM, G, (int)blockIdx.x);
        pg8::EpiOut E{(cbp)(ws + WS_X1B), args.out, mod + 5 * DM};
        pg8::gemm_phase<pg8::EpiOut, pg8::StaticOrder, true, true>(lds, g, S, E);
    }
#undef IN
#undef SEAM
}

extern "C" void kernel_launch(void* const* d_in, const int* in_sizes, int n_in, void* d_out, int out_size, void* d_ws, size_t ws_size, hipStream_t stream) {
    static int grid = 0;
    if (grid == 0) {
        if (n_in != 16 || out_size != MTOK * DM || ws_size < WS_END) { fprintf(stderr, "kernel_launch: unexpected shapes (n_in %d, out %d, ws %zu)\n", n_in, out_size, ws_size); grid = -1; return; }
        int dev = 0, cus = 0, per_cu = 0;
        if (hipGetDevice(&dev) != hipSuccess || hipDeviceGetAttribute(&cus, hipDeviceAttributeMultiprocessorCount, dev) != hipSuccess) { grid = -1; return; }
        if (hipFuncSetAttribute((const void*)mega_fwd, hipFuncAttributeMaxDynamicSharedMemorySize, LDS_BYTES) != hipSuccess) { fprintf(stderr, "kernel_launch: hipFuncSetAttribute failed\n"); grid = -1; return; }
        if (hipOccupancyMaxActiveBlocksPerMultiprocessor(&per_cu, (const void*)mega_fwd, NTHREADS, LDS_BYTES) != hipSuccess || per_cu < 1) { fprintf(stderr, "kernel_launch: occupancy query says %d\n", per_cu); (void)hipGetLastError(); grid = -1; return; }
        grid = cus;
    }
    if (grid < 0) return;
    (void)hipMemsetAsync((char*)d_ws + WS_MOD, 0, CTL_ZERO_BYTES, stream);
    Args a{};
    for (int i = 0; i < 16; ++i) a.in[i] = (const float*)d_in[i];
    a.out = (float*)d_out; a.ws = (unsigned char*)d_ws;
#if MK_N_LAUNCHES == 1
    a.ph_lo = 0; a.ph_hi = 10;
    void* kargs[] = {&a};
    hipError_t e = hipLaunchCooperativeKernel((const void*)mega_fwd, dim3(grid), dim3(NTHREADS), kargs, LDS_BYTES, stream);
    if (e != hipSuccess) fprintf(stderr, "cooperative launch failed: %s (grid %d)\n", hipGetErrorString(e), grid);
#else
    for (int p = 0; p < 10; ++p) { a.ph_lo = p; a.ph_hi = p + 1; hipLaunchKernelGGL(mega_fwd, dim3(grid), dim3(NTHREADS), LDS_BYTES, stream, a); }
#endif
}
```

```cpp
#include <hip/hip_runtime.h>
#include <hip/hip_cooperative_groups.h>
#include <cstdio>
#include <cstdint>
namespace cg = cooperative_groups;
#ifndef MK_N_LAUNCHES
#define MK_N_LAUNCHES 1
#endif
namespace pg8 {
#define PG8_LAS __attribute__((address_space(3)))
typedef unsigned short bf16_t;
typedef short bf16x8 __attribute__((ext_vector_type(8)));
typedef float f32x4 __attribute__((ext_vector_type(4)));
typedef unsigned u32x4 __attribute__((ext_vector_type(4)));
typedef int i32x4 __attribute__((ext_vector_type(4)));
typedef int i32x8 __attribute__((ext_vector_type(8)));
typedef unsigned u32x2 __attribute__((ext_vector_type(2)));
constexpr int BM = 256, BK = 64, HALF = 128, HTB = HALF * BK * 2  , STAGE_BYTES = 8 * HTB, NXCD = 8, WGM = 4;

__host__ __device__ __forceinline__ int lds_byte(int r, int c) { const int st = (r >> 4) * 2 + (c >> 5), rr = r & 15, cc = c & 31, ob = rr * 64 + cc * 2; return st * 1024 + (ob ^ (((ob >> 9) & 1) << 5)); }
__host__ __device__ __forceinline__ void stage_rc(int b, int& R, int& C) { const int st = b / 1024, sb = b % 1024, swz = sb ^ (((sb >> 9) & 1) << 5); R = (st >> 1) * 16 + swz / 64; C = (st & 1) * 32 + (swz % 64) / 2; }
__host__ __device__ __forceinline__ int perm32(int rho) { const int n = rho >> 4, i = rho & 15; return 8 * (i >> 2) + 4 * n + (i & 3); }

struct Unit { int pm, pn, kind; };
struct Gemm { const bf16_t* A; const bf16_t* Bt; int K, lda, ldb, a_pn_off, gap_at, gap, mid_t; const bf16_t* A2; const bf16_t* Bt2; };

struct StaticOrder {
    int nM, nN, nwg, G, c;
    __host__ __device__ void init(int M, int N, int G_, int c_) { nM = M / BM; nN = N / BM; nwg = nM * nN; G = G_; c = c_; }
    __host__ __device__ bool next(int i, Unit& u) const {
        const long L = (long)i * G + c; if (L >= nwg) return false;
        int wgid = (int)L; { const int q = nwg / NXCD, r = nwg % NXCD, xcd = wgid % NXCD, off = wgid / NXCD; wgid = (xcd < r ? xcd * (q + 1) : r * (q + 1) + (xcd - r) * q) + off; }
        const int nig = WGM * nN, gid = wgid / nig, fm = gid * WGM, gsz = (nM - fm) < WGM ? (nM - fm) : WGM;
        u.pm = fm + ((wgid % nig) % gsz); u.pn = (wgid % nig) / gsz; u.kind = 0; return true;
    }
    __device__ __forceinline__ void a_ready(const Unit&) const {}
    __device__ __forceinline__ void done(const Unit&) const {}
};
struct TwoGemmOrder {
    StaticOrder S0, S1; int G, c;
    __host__ __device__ void init(int M0, int N0, int M1, int N1, int G_, int c_) { S0.init(M0, N0, 1, 0); S1.init(M1, N1, 1, 0); G = G_; c = c_; }
    __host__ __device__ bool next(int i, Unit& u) const { const long L = (long)i * G + c;
        if (L < S0.nwg) return S0.next((int)L, u);
        if (L - S0.nwg < S1.nwg) { const bool ok = S1.next((int)(L - S0.nwg), u); u.kind = 1; return ok; }
        return false; }
    __device__ __forceinline__ void a_ready(const Unit&) const {}
    __device__ __forceinline__ void done(const Unit&) const {}
};


typedef float f32x2 __attribute__((ext_vector_type(2))); typedef __bf16 bf16x2_t __attribute__((ext_vector_type(2)));
__device__ __forceinline__ unsigned cvt_pk_bf16(float lo, float hi) { f32x2 v = {lo, hi}; bf16x2_t b = __builtin_convertvector(v, bf16x2_t); return __builtin_bit_cast(unsigned, b); }
__device__ __forceinline__ u32x4 pack8(f32x4 v0, f32x4 v1) { u32x4 w; w.x = cvt_pk_bf16(v0[0], v0[1]); w.y = cvt_pk_bf16(v0[2], v0[3]); w.z = cvt_pk_bf16(v1[0], v1[1]); w.w = cvt_pk_bf16(v1[2], v1[3]); return w; }
__device__ __forceinline__ float bf_lo(unsigned w) { return __uint_as_float(w << 16); }
__device__ __forceinline__ float bf_hi(unsigned w) { return __uint_as_float(w & 0xffff0000u); }
__device__ __forceinline__ float sigmoidf_(float x) { return __builtin_amdgcn_rcpf(1.0f + __expf(-x)); }

template <int MODE> struct EpiBf16 {
    static constexpr bool PERM = true, AFTER_DRAIN = false, HAS_MID = false;
    bf16_t* O; int ldc; const float* colscale;
    __device__ __forceinline__ void operator()(const f32x4 (&acc)[2][2][4][2], const Unit& u, int wr, int wc, int fr, int fq) const {
        const int row0 = u.pm * BM + wr * 64 + fr, col0 = u.pn * BM + wc * 32 + 8 * fq;
        f32x4 cs[2][2];
        if (MODE == 2) {
#pragma unroll
            for (int bj = 0; bj < 2; ++bj)
#pragma unroll
                for (int n = 0; n < 2; ++n) cs[bj][n] = *(const f32x4*)(colscale + col0 + bj * HALF + 4 * n);
        }
#pragma unroll
        for (int ai = 0; ai < 2; ++ai)
#pragma unroll
            for (int m = 0; m < 4; ++m) { bf16_t* rowp = O + (size_t)(row0 + ai * HALF + m * 16) * ldc + col0;
#pragma unroll
                for (int bj = 0; bj < 2; ++bj) { f32x4 v0 = acc[ai][bj][m][0], v1 = acc[ai][bj][m][1];
                    if (MODE == 1) {
#pragma unroll
                        for (int e = 0; e < 4; ++e) { const float a = fmaxf(v0[e], 0.f), b = fmaxf(v1[e], 0.f); v0[e] = a * a; v1[e] = b * b; } }
                    if (MODE == 2) { v0 = v0 * cs[bj][0]; v1 = v1 * cs[bj][1]; }
                    *(u32x4*)(rowp + bj * HALF) = pack8(v0, v1); } }
    }
};
struct EpiVF {
    static constexpr bool PERM = true, AFTER_DRAIN = false, HAS_MID = false;
    bf16_t* VF;
    __device__ __forceinline__ void operator()(const f32x4 (&acc)[2][2][4][2], const Unit& u, int wr, int wc, int fr, int fq) const {
        const int row0 = u.pm * BM + wr * 64 + fr, col0 = u.pn * BM + wc * 32 + 8 * fq;
#pragma unroll
        for (int ai = 0; ai < 2; ++ai)
#pragma unroll
            for (int m = 0; m < 4; ++m) { const int row = row0 + ai * HALF + m * 16, h = row >> 7, db = (row >> 5) & 3, r = row & 31;
#pragma unroll
                for (int bj = 0; bj < 2; ++bj) { const int c = col0 + bj * HALF, b = c >> 11, t = c & 2047, tile = t >> 5, s = (t >> 4) & 1, hh = (t >> 3) & 1;
                    const size_t off = ((((((size_t)(b * 8 + h) * 64 + tile) * 4 + db) * 2 + s) * 2 + hh) * 32 + r) * 8;
                    *(u32x4*)(VF + off) = pack8(acc[ai][bj][m][0], acc[ai][bj][m][1]); } }
    }
};
struct EpiP1 {
    static constexpr bool PERM = true, AFTER_DRAIN = false, HAS_MID = false;
    bf16_t* U; bf16_t* Q; bf16_t* KF; bf16_t* SG;
    __device__ __forceinline__ void operator()(const f32x4 (&acc)[2][2][4][2], const Unit& u, int wr, int wc, int fr, int fq) const {
        const int pn = u.pn + (u.pn >= 12 ? 4 : 0);
        const int row0 = u.pm * BM + wr * 64 + fr, cl = wc * 32 + 8 * fq;
        if (pn < 8) {
            bf16_t* base = pn < 4 ? U : Q; const int colt = (pn & 3) * 256;
#pragma unroll
            for (int ai = 0; ai < 2; ++ai)
#pragma unroll
                for (int m = 0; m < 4; ++m) { bf16_t* rowp = base + (size_t)(row0 + ai * HALF + m * 16) * 1024 + colt + cl;
#pragma unroll
                    for (int bj = 0; bj < 2; ++bj) *(u32x4*)(rowp + bj * HALF) = pack8(acc[ai][bj][m][0], acc[ai][bj][m][1]); }
        } else if (pn < 12) {
            const int sd = cl >> 4, hh = (cl >> 3) & 1;
#pragma unroll
            for (int ai = 0; ai < 2; ++ai)
#pragma unroll
                for (int m = 0; m < 4; ++m) { const int row = row0 + ai * HALF + m * 16, t = row & 2047, kk = t & 31, slot = (kk & ~12) | ((kk & 4) << 1) | ((kk & 8) >> 1);
#pragma unroll
                    for (int bj = 0; bj < 2; ++bj) { const int h = (pn - 8) * 2 + bj;
                        const size_t off = (((((size_t)((row >> 11) * 8 + h) * 64 + (t >> 5)) * 8 + sd) * 2 + hh) * 32 + slot) * 8;
                        *(u32x4*)(KF + off) = pack8(acc[ai][bj][m][0], acc[ai][bj][m][1]); } }
        } else {
            const int colt = (pn - 16) * 256;
            unsigned char* SG8 = (unsigned char*)SG;
#pragma unroll
            for (int ai = 0; ai < 2; ++ai)
#pragma unroll
                for (int m = 0; m < 4; ++m) { unsigned char* rowp = SG8 + (size_t)(row0 + ai * HALF + m * 16) * 4096 + colt + cl;
#pragma unroll
                    for (int bj = 0; bj < 2; ++bj) { const f32x4 v0 = acc[ai][bj][m][0], v1 = acc[ai][bj][m][1]; unsigned q[8];
#pragma unroll
                        for (int e = 0; e < 4; ++e) { q[e] = (unsigned)fminf(fmaxf(sigmoidf_(v0[e]) * 255.0f + 0.5f, 1.0f), 255.0f); q[4 + e] = (unsigned)fminf(fmaxf(sigmoidf_(v1[e]) * 255.0f + 0.5f, 1.0f), 255.0f); }
                        u32x2 w; w.x = q[0] | (q[1] << 8) | (q[2] << 16) | (q[3] << 24); w.y = q[4] | (q[5] << 8) | (q[6] << 16) | (q[7] << 24);
                        *(u32x2*)(rowp + bj * HALF) = w; } }
        }
    }
};
struct EpiGate8 {
    static constexpr bool PERM = true, AFTER_DRAIN = false, HAS_MID = false;
    unsigned char* SG8;
    __device__ __forceinline__ void operator()(const f32x4 (&acc)[2][2][4][2], const Unit& u, int wr, int wc, int fr, int fq) const {
        int t_ = threadIdx.x; asm volatile("" : "+v"(t_));
        const int l_ = t_ & 63, w_ = t_ >> 6; fr = l_ & 15; fq = l_ >> 4; wr = w_ >> 2; wc = w_ & 3;
        const int row0 = u.pm * BM + wr * 64 + fr, col0 = u.pn * BM + wc * 32 + 8 * fq;
#pragma unroll
        for (int ai = 0; ai < 2; ++ai)
#pragma unroll
            for (int m = 0; m < 4; ++m) { unsigned char* rowp = SG8 + (size_t)(row0 + ai * HALF + m * 16) * 4096 + col0;
#pragma unroll
                for (int bj = 0; bj < 2; ++bj) { const f32x4 v0 = acc[ai][bj][m][0] * 0.015625f, v1 = acc[ai][bj][m][1] * 0.015625f; unsigned q[8];
#pragma unroll
                    for (int e = 0; e < 4; ++e) { q[e] = (unsigned)fminf(fmaxf(sigmoidf_(v0[e]) * 255.0f + 0.5f, 1.0f), 255.0f); q[4 + e] = (unsigned)fminf(fmaxf(sigmoidf_(v1[e]) * 255.0f + 0.5f, 1.0f), 255.0f); }
                    u32x2 w; w.x = q[0] | (q[1] << 8) | (q[2] << 16) | (q[3] << 24); w.y = q[4] | (q[5] << 8) | (q[6] << 16) | (q[7] << 24);
                    *(u32x2*)(rowp + bj * HALF) = w; } }
    }
};
struct EpiP2 {
    static constexpr bool PERM = true, AFTER_DRAIN = false, HAS_MID = false;
    EpiP1 a; EpiVF b;
    __device__ __forceinline__ void operator()(const f32x4 (&acc)[2][2][4][2], const Unit& u, int wr, int wc, int fr, int fq) const { if (u.kind) b(acc, u, wr, wc, fr, fq); else a(acc, u, wr, wc, fr, fq); }
};
struct EpiGateMerge {
    static constexpr bool PERM = true, AFTER_DRAIN = false, HAS_MID = true;
    const unsigned char* SG8; bf16_t* O;
#define UB(w, i) ((float)(((w) >> (8 * (i))) & 0xffu))
    __device__ __forceinline__ void mid(f32x4 (&acc)[2][2][4][2], const Unit& u, int wr, int wc, int fr, int fq) const {
        const int row0 = u.pm * BM + wr * 64 + fr, col0 = u.pn * BM + wc * 32 + 8 * fq;
        const unsigned char* sp0 = SG8 + (size_t)row0 * 4096 + col0; asm volatile("" : "+v"(sp0));
#pragma unroll
        for (int ai = 0; ai < 2; ++ai)
#pragma unroll
            for (int m = 0; m < 4; ++m) { const unsigned char* sp = sp0 + (size_t)(ai * HALF + m * 16) * 4096;
#pragma unroll
                for (int bj = 0; bj < 2; ++bj) { const u32x2 ga = __builtin_nontemporal_load((const u32x2*)(sp + bj * HALF)), gb = __builtin_nontemporal_load((const u32x2*)(sp + 2048 + bj * HALF));
                    f32x4 r0, r1;
                    r0[0] = UB(gb.x, 0) * __builtin_amdgcn_rcpf(UB(ga.x, 0)); r0[1] = UB(gb.x, 1) * __builtin_amdgcn_rcpf(UB(ga.x, 1));
                    r0[2] = UB(gb.x, 2) * __builtin_amdgcn_rcpf(UB(ga.x, 2)); r0[3] = UB(gb.x, 3) * __builtin_amdgcn_rcpf(UB(ga.x, 3));
                    r1[0] = UB(gb.y, 0) * __builtin_amdgcn_rcpf(UB(ga.y, 0)); r1[1] = UB(gb.y, 1) * __builtin_amdgcn_rcpf(UB(ga.y, 1));
                    r1[2] = UB(gb.y, 2) * __builtin_amdgcn_rcpf(UB(ga.y, 2)); r1[3] = UB(gb.y, 3) * __builtin_amdgcn_rcpf(UB(ga.y, 3));
                    acc[ai][bj][m][0] *= r0; acc[ai][bj][m][1] *= r1; }
                if (m == 3) asm volatile("" ::: "memory"); }
    }
    __device__ __forceinline__ void operator()(const f32x4 (&acc)[2][2][4][2], const Unit& u, int wr, int wc, int fr, int fq) const {
        const int row0 = u.pm * BM + wr * 64 + fr, col0 = u.pn * BM + wc * 32 + 8 * fq;
        const float k = 1.0f / 255.0f;
#pragma unroll
        for (int ai = 0; ai < 2; ++ai)
#pragma unroll
            for (int m = 0; m < 4; ++m) { const size_t row = (size_t)(row0 + ai * HALF + m * 16);
#pragma unroll
                for (int bj = 0; bj < 2; ++bj) { const u32x2 g = __builtin_nontemporal_load((const u32x2*)(SG8 + row * 4096 + col0 + bj * HALF));
                    const f32x4 g0 = {UB(g.x, 0) * k, UB(g.x, 1) * k, UB(g.x, 2) * k, UB(g.x, 3) * k}, g1 = {UB(g.y, 0) * k, UB(g.y, 1) * k, UB(g.y, 2) * k, UB(g.y, 3) * k};
                    *(u32x4*)(O + row * 2048 + col0 + bj * HALF) = pack8(acc[ai][bj][m][0] * g0, acc[ai][bj][m][1] * g1); } }
    }
#undef UB
};
struct EpiResNorm {
    static constexpr bool PERM = true, AFTER_DRAIN = false, HAS_MID = false;
    const float* base; bf16_t* X1B; const float* mod; const float* nw; bf16_t* A2; float* rowsq;
    __device__ __forceinline__ void operator()(const f32x4 (&acc)[2][2][4][2], const Unit& u, int wr, int wc, int fr, int fq) const {
        const int row0 = u.pm * BM + wr * 64 + fr, col0 = u.pn * BM + wc * 32 + 8 * fq;
        const float* mb = mod + (size_t)(u.pm >> 3) * 12288 + col0;
        f32x4 gv[2][2], cs[2][2];
#pragma unroll
        for (int bj = 0; bj < 2; ++bj)
#pragma unroll
            for (int n = 0; n < 2; ++n) { gv[bj][n] = *(const f32x4*)(mb + 4096 + bj * HALF + 4 * n);
                cs[bj][n] = *(const f32x4*)(nw + col0 + bj * HALF + 4 * n) * (*(const f32x4*)(mb + 8192 + bj * HALF + 4 * n) + 1.0f); }
#pragma unroll
        for (int ai = 0; ai < 2; ++ai)
#pragma unroll
            for (int mp = 0; mp < 4; mp += 2) {
                f32x4 bs[2][2][2];
#pragma unroll
                for (int m2 = 0; m2 < 2; ++m2) { const size_t off = (size_t)(row0 + ai * HALF + (mp + m2) * 16) * 2048 + col0;
#pragma unroll
                    for (int bj = 0; bj < 2; ++bj)
#pragma unroll
                        for (int n = 0; n < 2; ++n) bs[m2][bj][n] = __builtin_nontemporal_load((const f32x4*)(base + off + bj * HALF + 4 * n)); }
                asm volatile("" ::: "memory");
#pragma unroll
                for (int m2 = 0; m2 < 2; ++m2) { const int row = row0 + ai * HALF + (mp + m2) * 16; const size_t off = (size_t)row * 2048 + col0; float q = 0.f;
#pragma unroll
                    for (int bj = 0; bj < 2; ++bj) { const f32x4 x0 = bs[m2][bj][0] + gv[bj][0] * acc[ai][bj][mp + m2][0], x1 = bs[m2][bj][1] + gv[bj][1] * acc[ai][bj][mp + m2][1];
                        *(u32x4*)(X1B + off + bj * HALF) = pack8(x0, x1);
                        q += ((x0[0] * x0[0] + x0[1] * x0[1]) + (x0[2] * x0[2] + x0[3] * x0[3])) + ((x1[0] * x1[0] + x1[1] * x1[1]) + (x1[2] * x1[2] + x1[3] * x1[3]));
                        *(u32x4*)(A2 + off + bj * HALF) = pack8(x0 * cs[bj][0], x1 * cs[bj][1]); }
                    q += __shfl_xor(q, 16); q += __shfl_xor(q, 32);
                    if (fq == 0) atomicAdd(rowsq + row, q); }
                asm volatile("" ::: "memory"); }
    }
};
struct EpiFF1 {
    static constexpr bool PERM = true, AFTER_DRAIN = false, HAS_MID = false;
    bf16_t* O; const float* rowsq; const float* bias2;
    __device__ __forceinline__ void operator()(const f32x4 (&acc)[2][2][4][2], const Unit& u, int wr, int wc, int fr, int fq) const {
        const int row0 = u.pm * BM + wr * 64 + fr, col0 = u.pn * BM + wc * 32 + 8 * fq;
        const float* bp = bias2 + (size_t)(u.pm >> 3) * 8192 + col0;
        float rs[2][4];
#pragma unroll
        for (int ai = 0; ai < 2; ++ai)
#pragma unroll
            for (int m = 0; m < 4; ++m) rs[ai][m] = rowsq[row0 + ai * HALF + m * 16];
        f32x4 bv[2][2];
#pragma unroll
        for (int bj = 0; bj < 2; ++bj)
#pragma unroll
            for (int n = 0; n < 2; ++n) bv[bj][n] = *(const f32x4*)(bp + bj * HALF + 4 * n);
#pragma unroll
        for (int ai = 0; ai < 2; ++ai)
#pragma unroll
            for (int m = 0; m < 4; ++m) { const float rstd = 1.0f / sqrtf(rs[ai][m] * (1.0f / 2048.0f) + 1e-6f);
                bf16_t* rowp = O + (size_t)(row0 + ai * HALF + m * 16) * 8192 + col0;
#pragma unroll
                for (int bj = 0; bj < 2; ++bj) { f32x4 v0 = acc[ai][bj][m][0] * rstd + bv[bj][0], v1 = acc[ai][bj][m][1] * rstd + bv[bj][1];
#pragma unroll
                    for (int e = 0; e < 4; ++e) { const float a = fmaxf(v0[e], 0.f), b = fmaxf(v1[e], 0.f); v0[e] = a * a; v1[e] = b * b; }
                    *(u32x4*)(rowp + bj * HALF) = pack8(v0, v1); } }
    }
};
struct EpiOut {
    static constexpr bool PERM = true, AFTER_DRAIN = false, HAS_MID = false;
    const bf16_t* X1B; float* out; const float* gate;
    __device__ __forceinline__ void operator()(const f32x4 (&acc)[2][2][4][2], const Unit& u, int wr, int wc, int fr, int fq) const {
        const int row0 = u.pm * BM + wr * 64 + fr, col0 = u.pn * BM + wc * 32 + 8 * fq;
        const float* gp = gate + (size_t)(u.pm >> 3) * 12288 + col0;
        f32x4 gv[2][2];
#pragma unroll
        for (int bj = 0; bj < 2; ++bj)
#pragma unroll
            for (int n = 0; n < 2; ++n) gv[bj][n] = *(const f32x4*)(gp + bj * HALF + 4 * n);
#pragma unroll
        for (int ai = 0; ai < 2; ++ai) {
            u32x4 xb[4][2];
#pragma unroll
            for (int m = 0; m < 4; ++m)
#pragma unroll
                for (int bj = 0; bj < 2; ++bj) xb[m][bj] = __builtin_nontemporal_load((const u32x4*)(X1B + (size_t)(row0 + ai * HALF + m * 16) * 2048 + col0 + bj * HALF));
#pragma unroll
            for (int m = 0; m < 4; ++m) { float* op = out + (size_t)(row0 + ai * HALF + m * 16) * 2048 + col0;
#pragma unroll
                for (int bj = 0; bj < 2; ++bj) { const u32x4 g = xb[m][bj];
                    const f32x4 x0 = {bf_lo(g.x), bf_hi(g.x), bf_lo(g.y), bf_hi(g.y)}, x1 = {bf_lo(g.z), bf_hi(g.z), bf_lo(g.w), bf_hi(g.w)};
                    *(f32x4*)(op + bj * HALF) = x0 + gv[bj][0] * acc[ai][bj][m][0]; *(f32x4*)(op + bj * HALF + 4) = x1 + gv[bj][1] * acc[ai][bj][m][1]; } }
        }
    }
};
struct EpiRes {
    static constexpr bool PERM = false, AFTER_DRAIN = false, HAS_MID = false;
    const float* base; float* out; const float* gate;
    __device__ __forceinline__ void operator()(const f32x4 (&acc)[2][2][4][2], const Unit& u, int wr, int wc, int fr, int fq) const {
        const int row0 = u.pm * BM + wr * 64 + fr, col0 = u.pn * BM + wc * 32 + 4 * fq;
        const float* gp = gate + (size_t)(u.pm >> 3) * 12288 + col0;
        f32x4 gv[2][2];
#pragma unroll
        for (int bj = 0; bj < 2; ++bj)
#pragma unroll
            for (int n = 0; n < 2; ++n) gv[bj][n] = *(const f32x4*)(gp + bj * HALF + n * 16);
#pragma unroll
        for (int ai = 0; ai < 2; ++ai)
#pragma unroll
            for (int m = 0; m < 4; ++m) { const size_t off = (size_t)(row0 + ai * HALF + m * 16) * 2048 + col0;
#pragma unroll
                for (int bj = 0; bj < 2; ++bj)
#pragma unroll
                    for (int n = 0; n < 2; ++n) { const f32x4 bs = __builtin_nontemporal_load((const f32x4*)(base + off + bj * HALF + n * 16)); *(f32x4*)(out + off + bj * HALF + n * 16) = bs + gv[bj][n] * acc[ai][bj][m][n]; } }
    }
};
template <class Epi, class Sched, bool ALIGN_EPI = false, bool SP2 = false, bool FP8 = false>
__device__ __forceinline__ void gemm_phase(PG8_LAS unsigned char* lds, const Gemm g, const Sched& S, const Epi& E) {
    int tid_ = threadIdx.x; asm volatile("" : "+v"(tid_));
    const int tid = tid_, wid = __builtin_amdgcn_readfirstlane(tid >> 6), lane = tid & 63, wr = wid >> 2, wc = wid & 3, fr = lane & 15, fq = lane >> 4;
    const int K = g.K, nt = K / BK;
    unsigned voffA[1], voffB[1];
    { int R, C; stage_rc(tid * 16, R, C); const int Rb = Epi::PERM ? ((R & ~31) + perm32(R & 31)) : R;
      voffA[0] = (unsigned)(R * g.lda + C) * 2u; voffB[0] = (unsigned)(Rb * g.ldb + C) * 2u; }
    const size_t voffA_step = (size_t)64 * g.lda * 2, voffB_step = (size_t)64 * g.ldb * 2;
    const size_t kstep = (size_t)(BK * 2);
    const size_t hstepA = (size_t)HALF * g.lda * 2, hstepB = (size_t)HALF * g.ldb * 2;
    const size_t tstepA = 2 * hstepA, tstepB = 2 * hstepB;
#define PG8_APTR(u) ((u).kind ? (const char*)g.A2 + (size_t)(u).pm * tstepA : (const char*)g.A + (size_t)(u).pm * tstepA + (size_t)(u).pn * (size_t)g.a_pn_off * 2)
#define PG8_BPTR(u) ((u).kind ? (const char*)g.Bt2 + (size_t)(u).pn * tstepB : (const char*)g.Bt + (size_t)((u).pn + ((u).pn >= g.gap_at ? g.gap : 0)) * tstepB)
    const unsigned ldsw = (unsigned)wid * 1024u;
    const int aoff = lds_byte(wr * 64 + fr, fq * 8), boff = lds_byte(wc * 32 + fr, fq * 8);
#define PG8_SA(b, h) (((b) * 2 + (h)) * HTB)
#define PG8_SB(b, h) ((4 + (b) * 2 + (h)) * HTB)
#define PG8_STAGE(bufoff, gbase, voff) do { _Pragma("unroll") for (int _i = 0; _i < 2; ++_i) \
        __builtin_amdgcn_global_load_lds((const unsigned*)((const char*)(gbase) + (size_t)_i * voff##_step + (voff)[0]), (PG8_LAS unsigned*)(lds + (bufoff) + ldsw + _i * 8192), 16, 0, 0); } while (0)
#define PG8_LDA(dst, b, h) do { if constexpr (FP8) { _Pragma("unroll") for (int m = 0; m < 4; ++m) dst##8[m] = __builtin_shufflevector(*(const PG8_LAS i32x4*)(lds + PG8_SA(b, h) + aoff + m * 2048), *(const PG8_LAS i32x4*)(lds + PG8_SA(b, h) + aoff + m * 2048 + 1024), 0, 1, 2, 3, 4, 5, 6, 7); } \
    else { _Pragma("unroll") for (int m = 0; m < 4; ++m) _Pragma("unroll") for (int k = 0; k < 2; ++k) dst[m][k] = *(const PG8_LAS bf16x8*)(lds + PG8_SA(b, h) + aoff + m * 2048 + k * 1024); } } while (0)
#define PG8_LDB(dst, b, h) do { if constexpr (FP8) { _Pragma("unroll") for (int n = 0; n < 2; ++n) dst##8[n] = __builtin_shufflevector(*(const PG8_LAS i32x4*)(lds + PG8_SB(b, h) + boff + n * 2048), *(const PG8_LAS i32x4*)(lds + PG8_SB(b, h) + boff + n * 2048 + 1024), 0, 1, 2, 3, 4, 5, 6, 7); } \
    else { _Pragma("unroll") for (int n = 0; n < 2; ++n) _Pragma("unroll") for (int k = 0; k < 2; ++k) dst[n][k] = *(const PG8_LAS bf16x8*)(lds + PG8_SB(b, h) + boff + n * 2048 + k * 1024); } } while (0)
#define PG8_MMA(ai, bj, At, Bt) do { __builtin_amdgcn_s_setprio(1); if constexpr (FP8) { _Pragma("unroll") for (int m = 0; m < 4; ++m) _Pragma("unroll") for (int n = 0; n < 2; ++n) \
        acc[ai][bj][m][n] = __builtin_amdgcn_mfma_scale_f32_16x16x128_f8f6f4(Bt##8[n], At##8[m], acc[ai][bj][m][n], 0, 0, 0, 0x7f7f7f7f, 0, 0x7f7f7f7f); } else { \
        _Pragma("unroll") for (int m = 0; m < 4; ++m) _Pragma("unroll") for (int n = 0; n < 2; ++n) _Pragma("unroll") for (int k = 0; k < 2; ++k) \
        acc[ai][bj][m][n] = __builtin_amdgcn_mfma_f32_16x16x32_bf16(Bt[n][k], At[m][k], acc[ai][bj][m][n], 0, 0, 0); } __builtin_amdgcn_s_setprio(0); } while (0)
#define PG8_WAIT_V(n) asm volatile("s_waitcnt vmcnt(" #n ")" ::: "memory")
#define PG8_WAIT_L(n) asm volatile("s_waitcnt lgkmcnt(" #n ")" ::: "memory")
#define PG8_BAR __builtin_amdgcn_s_barrier()
#define PG8_SCHED __builtin_amdgcn_sched_barrier(0)
    Unit cur, nxt; int ui = 0;
    if (!S.next(0, cur)) return;
    f32x4 acc[2][2][4][2];
#pragma unroll
    for (int a = 0; a < 2; ++a)
#pragma unroll
        for (int b = 0; b < 2; ++b)
#pragma unroll
            for (int m = 0; m < 4; ++m)
#pragma unroll
                for (int n = 0; n < 2; ++n) acc[a][b][m][n] = (f32x4){0.f, 0.f, 0.f, 0.f};
    bf16x8 At[4][2], B0[2][2], B1[2][2]; i32x8 At8[4], B08[2], B18[2];
    const char* cA = PG8_APTR(cur); const char* cB = PG8_BPTR(cur);
    S.a_ready(cur);
    if constexpr (SP2) {
        PG8_STAGE(PG8_SB(0, 0), cB, voffB); PG8_STAGE(PG8_SB(0, 1), cB + hstepB, voffB); PG8_STAGE(PG8_SA(0, 0), cA, voffA); PG8_STAGE(PG8_SA(0, 1), cA + hstepA, voffA);
        if (wr == 1) PG8_BAR;
        PG8_WAIT_V(2); PG8_BAR;
        PG8_STAGE(PG8_SB(1, 0), cB + kstep, voffB); PG8_STAGE(PG8_SA(1, 0), cA + kstep, voffA); PG8_STAGE(PG8_SB(1, 1), cB + hstepB + kstep, voffB);
        PG8_WAIT_V(6); PG8_BAR;
    } else {
        PG8_STAGE(PG8_SB(0, 0), cB, voffB); PG8_STAGE(PG8_SA(0, 0), cA, voffA); PG8_STAGE(PG8_SB(0, 1), cB + hstepB, voffB); PG8_STAGE(PG8_SA(0, 1), cA + hstepA, voffA);
        if (wr == 1) PG8_BAR;
        PG8_WAIT_V(4); PG8_BAR;
        PG8_STAGE(PG8_SB(1, 0), cB + kstep, voffB); PG8_STAGE(PG8_SA(1, 0), cA + kstep, voffA); PG8_STAGE(PG8_SB(1, 1), cB + hstepB + kstep, voffB);
        PG8_WAIT_V(6); PG8_BAR;
    }
    for (;;) {
        const bool has_next = S.next(ui + 1, nxt);
        const char* nA = has_next ? PG8_APTR(nxt) : cA; const char* nB = has_next ? PG8_BPTR(nxt) : cB;
        for (int t = 0; t < nt; t += 2) {
            if constexpr (Epi::HAS_MID) { if (t == g.mid_t) E.mid(acc, cur, wr, wc, fr, fq); }
            const bool last = (t == nt - 2);
            const char* a1 = cA + (size_t)(t + 1) * kstep;
            const char* a2 = last ? nA : cA + (size_t)(t + 2) * kstep; const char* b2 = last ? nB : cB + (size_t)(t + 2) * kstep;
            const char* a3 = a2 + kstep; const char* b3 = b2 + kstep;
            if (last && has_next) S.a_ready(nxt);
            if constexpr (SP2) {
            PG8_LDB(B0, 0, 0); PG8_LDB(B1, 0, 1); PG8_SCHED; PG8_LDA(At, 0, 0); PG8_STAGE(PG8_SA(1, 1), a1 + hstepA, voffA);
            PG8_WAIT_V(8); PG8_WAIT_L(0); PG8_BAR; PG8_MMA(0, 0, At, B0); PG8_MMA(0, 1, At, B1); PG8_BAR; PG8_SCHED;
            PG8_LDA(At, 0, 1); PG8_STAGE(PG8_SB(0, 0), b2, voffB); PG8_STAGE(PG8_SB(0, 1), b2 + hstepB, voffB); PG8_STAGE(PG8_SA(0, 0), a2, voffA);
            PG8_WAIT_V(8); PG8_WAIT_L(0); PG8_BAR; PG8_MMA(1, 0, At, B0); PG8_MMA(1, 1, At, B1); PG8_BAR; PG8_SCHED;
            PG8_LDB(B0, 1, 0); PG8_LDB(B1, 1, 1); PG8_SCHED; PG8_LDA(At, 1, 0); PG8_STAGE(PG8_SA(0, 1), a2 + hstepA, voffA);
            PG8_WAIT_V(8); PG8_WAIT_L(0); PG8_BAR; PG8_MMA(0, 0, At, B0); PG8_MMA(0, 1, At, B1); PG8_BAR; PG8_SCHED;
            PG8_LDA(At, 1, 1); PG8_STAGE(PG8_SB(1, 0), b3, voffB); PG8_STAGE(PG8_SB(1, 1), b3 + hstepB, voffB); PG8_STAGE(PG8_SA(1, 0), a3, voffA);
            PG8_WAIT_V(8); PG8_WAIT_L(0); PG8_BAR; PG8_MMA(1, 0, At, B0); PG8_MMA(1, 1, At, B1); PG8_BAR; PG8_SCHED;
            } else {
            PG8_LDB(B0, 0, 0); PG8_SCHED; PG8_LDA(At, 0, 0); PG8_STAGE(PG8_SA(1, 1), a1 + hstepA, voffA);
            PG8_WAIT_L(8); PG8_BAR; PG8_WAIT_L(0); PG8_MMA(0, 0, At, B0); PG8_BAR; PG8_SCHED;
            PG8_LDB(B1, 0, 1); PG8_STAGE(PG8_SB(0, 0), b2, voffB);
            PG8_BAR; PG8_WAIT_L(0); PG8_MMA(0, 1, At, B1); PG8_BAR;
            PG8_LDA(At, 0, 1); PG8_STAGE(PG8_SA(0, 0), a2, voffA);
            PG8_BAR; PG8_WAIT_L(0); PG8_MMA(1, 0, At, B0); PG8_BAR; PG8_SCHED;
            PG8_STAGE(PG8_SB(0, 1), b2 + hstepB, voffB);
            PG8_WAIT_V(6); PG8_BAR; PG8_MMA(1, 1, At, B1); PG8_BAR;
            PG8_LDB(B0, 1, 0); PG8_SCHED; PG8_LDA(At, 1, 0); PG8_STAGE(PG8_SA(0, 1), a2 + hstepA, voffA);
            PG8_WAIT_L(8); PG8_BAR; PG8_WAIT_L(0); PG8_MMA(0, 0, At, B0); PG8_BAR; PG8_SCHED;
            PG8_LDB(B1, 1, 1); PG8_STAGE(PG8_SB(1, 0), b3, voffB);
            PG8_BAR; PG8_WAIT_L(0); PG8_MMA(0, 1, At, B1); PG8_BAR;
            PG8_LDA(At, 1, 1); PG8_STAGE(PG8_SA(1, 0), a3, voffA);
            PG8_BAR; PG8_WAIT_L(0); PG8_MMA(1, 0, At, B0); PG8_BAR; PG8_SCHED;
            PG8_STAGE(PG8_SB(1, 1), b3 + hstepB, voffB);
            PG8_WAIT_V(6); PG8_BAR; PG8_MMA(1, 1, At, B1); PG8_BAR;
            }
        }
        if constexpr (ALIGN_EPI) { if (wr == 0) PG8_BAR; }
        if constexpr (!Epi::AFTER_DRAIN) { E(acc, cur, wr, wc, fr, fq); S.done(cur); }
        if (!has_next) break;
#pragma unroll
        for (int a = 0; a < 2; ++a)
#pragma unroll
            for (int b = 0; b < 2; ++b)
#pragma unroll
                for (int m = 0; m < 4; ++m)
#pragma unroll
                    for (int n = 0; n < 2; ++n) acc[a][b][m][n] = (f32x4){0.f, 0.f, 0.f, 0.f};
        cur = nxt; cA = nA; cB = nB; ++ui;
        if constexpr (ALIGN_EPI) { if (wr == 1) PG8_BAR; }
    }
    PG8_WAIT_V(0);
    if constexpr (!ALIGN_EPI) { if (wr == 0) PG8_BAR; }
    PG8_BAR;
    if constexpr (Epi::AFTER_DRAIN) { E.fused(acc, cur, wr, wc, fr, fq, lds, wid, lane); S.done(cur); }
#undef PG8_APTR
#undef PG8_BPTR
#undef PG8_SA
#undef PG8_SB
#undef PG8_STAGE
#undef PG8_LDA
#undef PG8_LDB
#undef PG8_MMA
#undef PG8_WAIT_V
#undef PG8_WAIT_L
#undef PG8_BAR
#undef PG8_SCHED
}
}

constexpr int NWAVES = 8, NTHREADS = NWAVES * 64;
constexpr int BATCH = 4, SEQ = 2048, DM = 2048, MTOK = BATCH * SEQ;
constexpr int PW = 1024, SBW = 1024, NH = 8, HD = 128, INW = 8192, DFF = 8192, NMOD = 6 * DM;
constexpr float EPS = 1e-6f;
constexpr size_t MiB = 1u << 20;
constexpr size_t WS_MOD = 0;
constexpr size_t CTL_ZERO_BYTES = 256 * 1024;
constexpr size_t WS_QUEUE = 196 * 1024;
constexpr size_t WS_BAR = 200 * 1024;
constexpr size_t WS_ROWSQ = 216 * 1024;
constexpr size_t WS_BIAS2 = 113 * MiB + 512 * 1024;
constexpr size_t WS_X1B = 306 * MiB;
constexpr size_t WS_A2 = 274 * MiB;
constexpr size_t WS_WIN = 1 * MiB, WS_WFF1 = 33 * MiB, WS_WFF2 = 65 * MiB, WS_WO = 97 * MiB, WS_WBA = 105 * MiB, WS_WPOOL = 113 * MiB;
constexpr size_t WS_H = 114 * MiB;
constexpr size_t WS_R = 146 * MiB;
constexpr size_t WS_U = WS_R, WS_Q = WS_R + 32 * MiB, WS_K = WS_R + 48 * MiB, WS_VT = WS_R + 64 * MiB, WS_POOLED = WS_R + 80 * MiB, WS_AM = WS_R + 96 * MiB;
constexpr size_t WS_F1 = WS_R;
constexpr size_t WS_SG = 274 * MiB, WS_H8 = 338 * MiB, WS_END = 354 * MiB;
constexpr size_t WS_WG8 = WS_WIN + 16 * MiB;
constexpr int LDS_BYTES = 131072 + 1024;

#define LAS __attribute__((address_space(3)))
typedef unsigned short bf16;
typedef unsigned v4u __attribute__((ext_vector_type(4)));
typedef unsigned v2u __attribute__((ext_vector_type(2)));
typedef float f32x4 __attribute__((ext_vector_type(4)));
typedef float f32x16 __attribute__((ext_vector_type(16)));
typedef short bf16x8 __attribute__((ext_vector_type(8)));
#define LDS_WAIT() asm volatile("s_waitcnt lgkmcnt(0)" ::: "memory")
using pg8::cvt_pk_bf16;

__device__ __forceinline__ float wave_sum(float v) {
#pragma unroll
    for (int o = 1; o < 64; o <<= 1) v += __shfl_xor(v, o);
    return v;
}
__device__ __forceinline__ void p0_transpose_item(const float* W, int K, int N, bf16* WT, int ldt, LAS unsigned short* T, int item, int lane) {
    const int nblk = N / 64, kb = item / nblk, nb = item % nblk, k0 = 64 * kb, n0 = 64 * nb;
    const int row = lane >> 4, n4 = lane & 15;
    f32x4 v[16];
#pragma unroll
    for (int i = 0; i < 16; ++i) v[i] = __builtin_nontemporal_load((const f32x4*)(W + (size_t)(k0 + 4 * i + row) * N + n0 + 4 * n4));
#pragma unroll
    for (int i = 0; i < 16; ++i) { const int k = 4 * i + row; const unsigned p01 = cvt_pk_bf16(v[i].x, v[i].y), p23 = cvt_pk_bf16(v[i].z, v[i].w);
        T[(4 * n4 + 0) * 66 + k] = (unsigned short)p01; T[(4 * n4 + 1) * 66 + k] = (unsigned short)(p01 >> 16);
        T[(4 * n4 + 2) * 66 + k] = (unsigned short)p23; T[(4 * n4 + 3) * 66 + k] = (unsigned short)(p23 >> 16); }
    LDS_WAIT(); asm volatile("" ::: "memory");
    const int kc = lane & 7;
#pragma unroll
    for (int j = 0; j < 8; ++j) { const int n = (lane >> 3) + 8 * j; const LAS unsigned* tp = (const LAS unsigned*)(T + n * 66 + 8 * kc);
        v4u o; o.x = tp[0]; o.y = tp[1]; o.z = tp[2]; o.w = tp[3];
        *(v4u*)(WT + (size_t)(n0 + n) * ldt + k0 + 8 * kc) = o; }
    LDS_WAIT(); asm volatile("" ::: "memory");
}


#define XB_TMO      128
#define XB_XCNT(j)  (256  + 64 * (j))
#define XB_XSUB(j)  (1280 + 64 * (j))
#define XB_XGEN(j)  (2304 + 64 * (j))
#define XB_TOP      3328
#define XB_TOPGEN   3392
#define XCD_BAR_WORDS 3456
#define XB_SPIN_CAP (1u << 18)

__device__ __forceinline__ unsigned xb_ld(unsigned* p)              { return __hip_atomic_load(p, __ATOMIC_RELAXED, __HIP_MEMORY_SCOPE_AGENT); }
__device__ __forceinline__ unsigned xb_add(unsigned* p, unsigned v) { return __hip_atomic_fetch_add(p, v, __ATOMIC_RELAXED, __HIP_MEMORY_SCOPE_AGENT); }
__device__ __forceinline__ unsigned xb_xcc_id() { return (unsigned)__builtin_amdgcn_s_getreg((3 << 11) | 20) & 0xFu; }
#define XB_SPIN(cond, bar) do { unsigned _sp = 0; while (cond) { __builtin_amdgcn_s_sleep(1); \
    if ((++_sp & 255u) == 0u) { if (xb_ld(&(bar)[XB_TMO])) break; if (_sp > XB_SPIN_CAP) { atomicAdd(&(bar)[XB_TMO], 1u); break; } } } } while (0)

struct XcdBarrier {
    unsigned* bar; unsigned x;
    volatile LAS unsigned* st;
};

__device__ __forceinline__ XcdBarrier xcd_barrier_post(unsigned* bar, volatile LAS unsigned* st) {
    XcdBarrier b; b.bar = bar; b.x = xb_xcc_id(); b.st = st;
    if (threadIdx.x == 0) (void)xb_add(&bar[XB_XCNT(b.x)], 1u);
    return b;
}
__device__ __forceinline__ void xcd_barrier_complete(unsigned* bar, unsigned x, unsigned& nloc, unsigned& nx) {
    const unsigned G = gridDim.x * gridDim.y * gridDim.z;
    unsigned sum, cnt, mine, sp = 0u;
    for (;;) {
        sum = 0u; cnt = 0u; mine = 0u;
#pragma unroll
        for (unsigned j = 0; j < 16; ++j) { const unsigned c = xb_ld(&bar[XB_XCNT(j)]); sum += c; cnt += (c > 0u) ? 1u : 0u; mine = (j == x) ? c : mine; }
        if (sum == G) break;
        __builtin_amdgcn_s_sleep(1);
        if ((++sp & 255u) == 0u) { if (xb_ld(&bar[XB_TMO])) break; if (sp > XB_SPIN_CAP) { atomicAdd(&bar[XB_TMO], 1u); break; } }
    }
    nloc = mine > 0u ? mine : 1u; nx = cnt > 0u ? cnt : 1u;
}

__device__ __forceinline__ void xcd_barrier(const XcdBarrier& b) {
    asm volatile("s_waitcnt vmcnt(0)" ::: "memory");
    __syncthreads();
    if (threadIdx.x == 0) {
        unsigned* bar = b.bar;
        __builtin_amdgcn_s_waitcnt(0);
        unsigned nloc = b.st[0], nx = b.st[1];
        if (nloc == 0u) { xcd_barrier_complete(bar, b.x, nloc, nx); b.st[0] = nloc; b.st[1] = nx; }
        const unsigned old = xb_add(&bar[XB_XSUB(b.x)], 1u);
        const unsigned gen = old / nloc;
        if (old + 1u == (gen + 1u) * nloc) {
            __builtin_amdgcn_fence(__ATOMIC_RELEASE, "agent");
            asm volatile("s_waitcnt vmcnt(0)" ::: "memory");
            const unsigned og = xb_add(&bar[XB_TOP], 1u);
            const unsigned tg = og / nx;
            if (og + 1u == (tg + 1u) * nx) xb_add(&bar[XB_TOPGEN], 1u);
            else XB_SPIN(xb_ld(&bar[XB_TOPGEN]) == tg, bar);
            __builtin_amdgcn_fence(__ATOMIC_ACQUIRE, "agent");
            xb_add(&bar[XB_XGEN(b.x)], 1u);
            asm volatile("s_waitcnt vmcnt(0)" ::: "memory");
        } else {
            XB_SPIN(xb_ld(&bar[XB_XGEN(b.x)]) == gen, bar);
            __builtin_amdgcn_fence(__ATOMIC_ACQUIRE, "agent");
            asm volatile("s_waitcnt vmcnt(0)" ::: "memory");
        }
    }
    __syncthreads();
}

struct Args { const float* in[16]; float* out; unsigned char* ws; int ph_lo, ph_hi; };

__device__ __forceinline__ void p0_transpose_item_f8(const float* W, int N, unsigned char* W8, int ld8, int ncol0, LAS unsigned short* T, int item, int lane) {
    const int nblk = N / 64, kb = item / nblk, nb = item % nblk, k0 = 64 * kb, n0 = 64 * nb;
    const int row = lane >> 4, n4 = lane & 15;
    f32x4 v[16];
#pragma unroll
    for (int i = 0; i < 16; ++i) v[i] = __builtin_nontemporal_load((const f32x4*)(W + (size_t)(k0 + 4 * i + row) * N + n0 + 4 * n4));
#pragma unroll
    for (int i = 0; i < 16; ++i) { const int k = 4 * i + row; const unsigned p01 = cvt_pk_bf16(v[i].x, v[i].y), p23 = cvt_pk_bf16(v[i].z, v[i].w);
        T[(4 * n4 + 0) * 66 + k] = (unsigned short)p01; T[(4 * n4 + 1) * 66 + k] = (unsigned short)(p01 >> 16);
        T[(4 * n4 + 2) * 66 + k] = (unsigned short)p23; T[(4 * n4 + 3) * 66 + k] = (unsigned short)(p23 >> 16); }
    LDS_WAIT(); asm volatile("" ::: "memory");
    const int pc = lane & 3;
#pragma unroll
    for (int j = 0; j < 4; ++j) { const int n = (lane >> 2) + 16 * j; const LAS unsigned* tp = (const LAS unsigned*)(T + n * 66 + 16 * pc);
        v4u o;
#pragma unroll
        for (int d = 0; d < 4; ++d) { const unsigned w0 = tp[2 * d], w1 = tp[2 * d + 1];
            int p = __builtin_amdgcn_cvt_pk_fp8_f32(pg8::bf_lo(w0) * 64.0f, pg8::bf_hi(w0) * 64.0f, 0, false);
            p = __builtin_amdgcn_cvt_pk_fp8_f32(pg8::bf_lo(w1) * 64.0f, pg8::bf_hi(w1) * 64.0f, p, true); o[d] = (unsigned)p; }
        *(v4u*)(W8 + (size_t)(n0 - ncol0 + n) * ld8 + k0 + 16 * pc) = o; }
    LDS_WAIT(); asm volatile("" ::: "memory");
}

__device__ __forceinline__ void phase0(const Args& a, LAS unsigned char* lds, int tid, int lane, int wave, int G, bool do_atomics) {
    const float* c = a.in[1]; const float* w_ada = a.in[2]; const float* b_ada = a.in[3];
    float* mod = (float*)(a.ws + WS_MOD);
    unsigned* qhead = (unsigned*)(a.ws + WS_QUEUE) + (do_atomics ? 0 : 64);
    LAS float* sc = (LAS float*)lds;
    LAS float* red = (LAS float*)(lds + 8192);
    LAS unsigned short* T = (LAS unsigned short*)(lds + 8192 + wave * 8448);
    volatile LAS unsigned* slot = (volatile LAS unsigned*)(lds + 131072 + 512);
    constexpr int I_IN = (DM / 64) * (INW / 64), I_F1 = (DM / 64) * (DFF / 64), I_F2 = (DFF / 64) * (DM / 64), I_O = (DM / 64) * (DM / 64), I_A = (PW / 64) * (DM / 64), I_B = (SBW / 64) * (DM / 64), I_P = 4 * 4 * 4;
    constexpr int NITEMS = I_IN + I_F1 + I_F2 + I_O + I_A + I_B + I_P, NROUNDS = 192 + NITEMS / 8;
    static_assert(NITEMS % 8 == 0, "transpose items come in rounds of 8 (one per wave)");
    for (;;) {
        __syncthreads();
        if (tid == 0) slot[0] = __hip_atomic_fetch_add(qhead, 1u, __ATOMIC_RELAXED, __HIP_MEMORY_SCOPE_AGENT);
        __syncthreads();
        const int rd = (int)slot[0];
        if (rd >= NROUNDS) break;
        if (rd < 192) {
            const int cc = rd % 48, kc = rd / 48;
            for (int idx = tid; idx < 2048; idx += NTHREADS) { const float cv = c[(idx >> 9) * DM + kc * 512 + (idx & 511)]; sc[idx] = cv / (1.0f + __expf(-cv)); }
            __syncthreads();
            f32x4 acc[4];
#pragma unroll
            for (int b = 0; b < 4; ++b) acc[b] = (f32x4){0.f, 0.f, 0.f, 0.f};
            const float* wp = w_ada + (size_t)(kc * 512 + wave * 64) * NMOD + cc * 256 + lane * 4;
#pragma unroll 8
            for (int i = 0; i < 64; ++i) { const f32x4 w4 = __builtin_nontemporal_load((const f32x4*)(wp + (size_t)i * NMOD));
#pragma unroll
                for (int b = 0; b < 4; ++b) acc[b] += sc[b * 512 + wave * 64 + i] * w4; }
#pragma unroll
            for (int b = 0; b < 4; ++b) *(LAS f32x4*)(red + (wave * 4 + b) * 256 + lane * 4) = acc[b];
            __syncthreads();
#pragma unroll
            for (int e = 0; e < 2; ++e) { const int idx = tid + 512 * e, b = idx >> 8, col = idx & 255; float s = 0.f;
#pragma unroll
                for (int w = 0; w < 8; ++w) s += red[(w * 4 + b) * 256 + col];
                if (kc == 0) s += b_ada[cc * 256 + col];
                if (do_atomics) atomicAdd(mod + b * NMOD + cc * 256 + col, s); }
        } else {
            int r = (rd - 192) * 8 + wave;
            if (r < I_IN) { if ((r % (INW / 64)) >= 64) p0_transpose_item_f8(a.in[5], INW, a.ws + WS_WG8, DM, 4096, T, r, lane);
                            else p0_transpose_item(a.in[5], DM, INW, (bf16*)(a.ws + WS_WIN), DM, T, r, lane); continue; } r -= I_IN;
            if (r < I_F1) { p0_transpose_item(a.in[14], DM, DFF, (bf16*)(a.ws + WS_WFF1), DM, T, r, lane); continue; } r -= I_F1;
            if (r < I_F2) { p0_transpose_item(a.in[15], DFF, DM, (bf16*)(a.ws + WS_WFF2), DFF, T, r, lane); continue; } r -= I_F2;
            if (r < I_O) { p0_transpose_item(a.in[12], DM, DM, (bf16*)(a.ws + WS_WO), DM, T, r, lane); continue; } r -= I_O;
            if (r < I_A) { p0_transpose_item(a.in[10], PW, DM, (bf16*)(a.ws + WS_WBA) + SBW, DM, T, r, lane); continue; } r -= I_A;
            if (r < I_B) { p0_transpose_item(a.in[11], SBW, DM, (bf16*)(a.ws + WS_WBA), DM, T, r, lane); continue; } r -= I_B;
            { const int g = r >> 4; p0_transpose_item(a.in[8] + (size_t)g * 65536, 256, 256, (bf16*)(a.ws + WS_WPOOL) + (size_t)g * 65536, 256, T, r & 15, lane); }
        }
    }
}

__device__ __forceinline__ void norm_mod_rows(const float* X, const float* nw, const float* mod, int shift_off, int scale_off, bf16* O, unsigned char* O8, int lane, int gw, int NGW) {
    for (int m0 = gw * 4; m0 < MTOK; m0 += NGW * 4) {
        const float* mb = mod + (size_t)(m0 >> 11) * NMOD;
        f32x4 cs[8], sh[8];
#pragma unroll
        for (int j = 0; j < 8; ++j) { const int col = 4 * (lane + 64 * j); cs[j] = *(const f32x4*)(nw + col) * (*(const f32x4*)(mb + scale_off + col) + 1.0f); sh[j] = *(const f32x4*)(mb + shift_off + col); }
#pragma unroll 1
        for (int hr = 0; hr < 4; hr += 2) {
            f32x4 v[2][8];
#pragma unroll
            for (int r = 0; r < 2; ++r)
#pragma unroll
                for (int j = 0; j < 8; ++j) v[r][j] = __builtin_nontemporal_load((const f32x4*)(X + (size_t)(m0 + hr + r) * DM) + lane + 64 * j);
            float ss[2];
#pragma unroll
            for (int r = 0; r < 2; ++r) { float s = 0.f;
#pragma unroll
                for (int j = 0; j < 8; ++j) s += (v[r][j].x * v[r][j].x + v[r][j].y * v[r][j].y) + (v[r][j].z * v[r][j].z + v[r][j].w * v[r][j].w);
                ss[r] = s; }
#pragma unroll
            for (int o = 1; o < 64; o <<= 1) { ss[0] += __shfl_xor(ss[0], o); ss[1] += __shfl_xor(ss[1], o); }
#pragma unroll
            for (int r = 0; r < 2; ++r) { const float rstd = 1.0f / sqrtf(ss[r] * (1.0f / DM) + EPS);
                v2u* o8 = (v2u*)(O + (size_t)(m0 + hr + r) * DM) + lane;
#pragma unroll
                for (int j = 0; j < 8; ++j) { const f32x4 y = (v[r][j] * rstd) * cs[j] + sh[j];
                    v2u p; p.x = cvt_pk_bf16(y.x, y.y); p.y = cvt_pk_bf16(y.z, y.w); o8[64 * j] = p;
                    { int q = __builtin_amdgcn_cvt_pk_fp8_f32(y.x, y.y, 0, false); q = __builtin_amdgcn_cvt_pk_fp8_f32(y.z, y.w, q, true); *((unsigned*)(O8 + (size_t)(m0 + hr + r) * DM) + lane + 64 * j) = (unsigned)q; } } }
        }
    }
}

template <int W> __device__ __forceinline__ void pool_chunk(const v2u* U4, v2u* P4, int m0, int c4) {
    const bool first = (m0 & (SEQ - 1)) == 0;
    v2u raw[16 + W - 1];
#pragma unroll
    for (int i = 0; i < 16 + W - 1; ++i) { const int tt = i - (W - 1);
        if (tt >= 0 || !first) raw[i] = __builtin_nontemporal_load(U4 + (size_t)(m0 + tt) * 256 + c4); else raw[i] = (v2u){0u, 0u}; }
#define PC_V(i) ((f32x4){pg8::bf_lo(raw[i].x), pg8::bf_hi(raw[i].x), pg8::bf_lo(raw[i].y), pg8::bf_hi(raw[i].y)})
    f32x4 s = {0.f, 0.f, 0.f, 0.f};
#pragma unroll
    for (int i = 0; i < W - 1; ++i) s += PC_V(i);
#pragma unroll
    for (int i = 0; i < 16; ++i) { const f32x4 self = PC_V(W - 1 + i); s += self;
        const float inv = (first && i + 1 < W) ? 1.0f / (float)(i + 1) : 1.0f / (float)W;
        const f32x4 r = s * inv - self; s -= PC_V(i);
        v2u p; p.x = cvt_pk_bf16(r.x, r.y); p.y = cvt_pk_bf16(r.z, r.w);
        P4[(size_t)(m0 + i) * 256 + c4] = p; }
#undef PC_V
}
__device__ __forceinline__ void attn_unit(int unit, const bf16* Q, const bf16* K, const bf16* VT, bf16* O, const float* qw, const float* kw, int lane) {
    const int qb = unit & 63, bh = unit >> 6, b = bh >> 3, h = bh & 7;
    const int r = lane & 31, hh = lane >> 5, q0 = qb * 32;
    const size_t rowbase = (size_t)b * SEQ;
    const float scale = 0.08838834764831845f;
    bf16x8 qf[8];
    { const bf16* qp = Q + (rowbase + q0 + r) * 1024 + h * HD + 8 * hh;
      v4u qraw[8];
#pragma unroll
      for (int s = 0; s < 8; ++s) qraw[s] = *(const v4u*)(qp + 16 * s);
      float ssq = 0.f;
#pragma unroll
      for (int s = 0; s < 8; ++s)
#pragma unroll
          for (int e = 0; e < 4; ++e) { const float a0 = pg8::bf_lo(qraw[s][e]), a1 = pg8::bf_hi(qraw[s][e]); ssq += a0 * a0 + a1 * a1; }
      ssq += __shfl_xor(ssq, 32);
      const float rq = scale / sqrtf(ssq * (1.0f / HD) + EPS);
#pragma unroll
      for (int s = 0; s < 8; ++s) { const int d0 = 16 * s + 8 * hh;
          const f32x4 wa0 = *(const f32x4*)(qw + d0), wa1 = *(const f32x4*)(qw + d0 + 4), wb0 = *(const f32x4*)(kw + d0), wb1 = *(const f32x4*)(kw + d0 + 4);
          const f32x4 c0 = wa0 * wb0 * rq, c1 = wa1 * wb1 * rq;
          v4u w; w.x = cvt_pk_bf16(pg8::bf_lo(qraw[s].x) * c0[0], pg8::bf_hi(qraw[s].x) * c0[1]); w.y = cvt_pk_bf16(pg8::bf_lo(qraw[s].y) * c0[2], pg8::bf_hi(qraw[s].y) * c0[3]);
          w.z = cvt_pk_bf16(pg8::bf_lo(qraw[s].z) * c1[0], pg8::bf_hi(qraw[s].z) * c1[1]); w.w = cvt_pk_bf16(pg8::bf_lo(qraw[s].w) * c1[2], pg8::bf_hi(qraw[s].w) * c1[3]);
          qf[s] = __builtin_bit_cast(bf16x8, w); } }
    f32x16 o[4];
#pragma unroll
    for (int d = 0; d < 4; ++d)
#pragma unroll
        for (int i = 0; i < 16; ++i) o[d][i] = 0.f;
    float R = 0.f;
    const int qpos = q0 + r;
    bf16x8 kf[8];
    const bf16* kfb = K + (size_t)bh * 64 * 8 * 64 * 8 + lane * 8;
    const bf16* vfb = VT + (size_t)bh * 64 * 8 * 64 * 8 + lane * 8;
    { const bf16* kp = kfb + (size_t)qb * 4096;
#pragma unroll
      for (int s = 0; s < 8; ++s) kf[s] = *(const bf16x8*)(kp + 512 * s); }
    for (int kt = qb; ; --kt) {
        const int k0 = kt * 32;
        float ksq = 0.f;
#pragma unroll
        for (int s = 0; s < 8; ++s) { const v4u w = __builtin_bit_cast(v4u, kf[s]);
#pragma unroll
            for (int e = 0; e < 4; ++e) { const float a0 = pg8::bf_lo(w[e]), a1 = pg8::bf_hi(w[e]); ksq += a0 * a0 + a1 * a1; } }
        ksq += __shfl_xor(ksq, 32);
        const float rk = 1.0f / sqrtf(ksq * (1.0f / HD) + EPS);
        f32x16 sa;
#pragma unroll
        for (int i = 0; i < 16; ++i) sa[i] = 0.f;
#pragma unroll
        for (int s = 0; s < 8; ++s) sa = __builtin_amdgcn_mfma_f32_32x32x16_bf16(kf[s], qf[s], sa, 0, 0, 0);
        const bf16* vp = vfb + (size_t)kt * 4096;
        bf16x8 vf[4][2];
#pragma unroll
        for (int d = 0; d < 4; ++d)
#pragma unroll
            for (int s = 0; s < 2; ++s) vf[d][s] = *(const bf16x8*)(vp + (d * 2 + s) * 512);
        { const bf16* kp = kfb + (size_t)(kt > 0 ? kt - 1 : 0) * 4096;
#pragma unroll
          for (int s = 0; s < 8; ++s) kf[s] = *(const bf16x8*)(kp + 512 * s); }
        float l[16], lb[16];
        const int kbase = k0 + 8 * hh;
#pragma unroll
        for (int i = 0; i < 16; ++i) { const float z = sa[i] * __shfl(rk, (((i >> 3) << 4) | (((i >> 2) & 1) << 3) | (i & 3)) + 4 * hh);
            const float sp = fmaxf(z, 0.f) + __logf(1.0f + __expf(-fabsf(z)));
            const bool valid = (kbase + 16 * (i >> 3) + (i & 7)) < qpos;
            l[i] = valid ? -sp : 0.f; lb[i] = valid ? z - sp : -INFINITY; }
        float ra = 0.f, rb = 0.f;
#pragma unroll
        for (int i = 0; i < 8; ++i) { ra += l[i]; rb += l[8 + i]; }
        const float oa = __shfl_xor(ra, 32), ob = __shfl_xor(rb, 32);
        const float T = (ra + oa) + (rb + ob);
        float sufa = R + (hh == 0 ? (oa + (rb + ob)) : (ob + rb));
        float sufb = R + (hh == 0 ? ob : 0.f);
        float p[16];
#pragma unroll
        for (int i = 7; i >= 0; --i) { p[i] = __expf(lb[i] + sufa); sufa += l[i]; p[8 + i] = __expf(lb[8 + i] + sufb); sufb += l[8 + i]; }
        R += T;
        v4u pf[2];
#pragma unroll
        for (int s = 0; s < 2; ++s) { pf[s].x = cvt_pk_bf16(p[8 * s], p[8 * s + 1]); pf[s].y = cvt_pk_bf16(p[8 * s + 2], p[8 * s + 3]); pf[s].z = cvt_pk_bf16(p[8 * s + 4], p[8 * s + 5]); pf[s].w = cvt_pk_bf16(p[8 * s + 6], p[8 * s + 7]); }
#pragma unroll
        for (int d = 0; d < 4; ++d)
#pragma unroll
            for (int s = 0; s < 2; ++s) o[d] = __builtin_amdgcn_mfma_f32_32x32x16_bf16(vf[d][s], __builtin_bit_cast(bf16x8, pf[s]), o[d], 0, 0, 0);
        if (kt == 0 || __all(R < -88.0f)) break;
    }
    bf16* op = O + (rowbase + q0 + r) * 2048 + h * HD + 4 * hh;
#pragma unroll
    for (int d = 0; d < 4; ++d)
#pragma unroll
        for (int i4 = 0; i4 < 4; ++i4) { v2u w; w.x = cvt_pk_bf16(o[d][4 * i4], o[d][4 * i4 + 1]); w.y = cvt_pk_bf16(o[d][4 * i4 + 2], o[d][4 * i4 + 3]); *(v2u*)(op + 32 * d + 8 * i4) = w; }
}

__device__ __forceinline__ void bias2_gemv(const Args& a, int lane, int gw2, int NGW2) {
    const bf16* WT = (const bf16*)(a.ws + WS_WFF1); const float* modp = (const float*)(a.ws + WS_MOD) + 3 * DM; float* B2 = (float*)(a.ws + WS_BIAS2);
    f32x4 sh[4][4][2];
#pragma unroll
    for (int bb = 0; bb < 4; ++bb)
#pragma unroll
        for (int j = 0; j < 4; ++j)
#pragma unroll
            for (int h2 = 0; h2 < 2; ++h2) sh[bb][j][h2] = *(const f32x4*)(modp + (size_t)bb * NMOD + (j * 64 + lane) * 8 + 4 * h2);
    for (int n = gw2; n < DFF; n += NGW2) {
        v4u w[4];
#pragma unroll
        for (int j = 0; j < 4; ++j) w[j] = *(const v4u*)(WT + (size_t)n * DM + (j * 64 + lane) * 8);
        float sb[4] = {0.f, 0.f, 0.f, 0.f};
#pragma unroll
        for (int j = 0; j < 4; ++j) { const f32x4 w0 = {pg8::bf_lo(w[j].x), pg8::bf_hi(w[j].x), pg8::bf_lo(w[j].y), pg8::bf_hi(w[j].y)}, w1 = {pg8::bf_lo(w[j].z), pg8::bf_hi(w[j].z), pg8::bf_lo(w[j].w), pg8::bf_hi(w[j].w)};
#pragma unroll
            for (int bb = 0; bb < 4; ++bb) { const f32x4 p = sh[bb][j][0] * w0 + sh[bb][j][1] * w1; sb[bb] += (p[0] + p[1]) + (p[2] + p[3]); } }
#pragma unroll
        for (int bb = 0; bb < 4; ++bb) sb[bb] = wave_sum(sb[bb]);
        if (lane == 0) { B2[n] = sb[0]; B2[DFF + n] = sb[1]; B2[2 * DFF + n] = sb[2]; B2[3 * DFF + n] = sb[3]; }
    }
}
__global__ void __launch_bounds__(NTHREADS, 2) mega_fwd(Args args) {
    extern __shared__ __attribute__((aligned(16))) unsigned char lds_raw[];
    LAS unsigned char* lds = (LAS unsigned char*)lds_raw;
    const int G = gridDim.x, NGW = G * NWAVES;
    { int t0_ = threadIdx.x; if (t0_ < 64) ((LAS unsigned*)(lds + 131072))[t0_] = 0u; }
    __syncthreads();
    const XcdBarrier bar = xcd_barrier_post((unsigned*)(args.ws + WS_BAR), (volatile LAS unsigned*)(lds + 131072));
#define FRESH_IDS() int tid = threadIdx.x; asm volatile("" : "+v"(tid)); const int lane = tid & 63, wave = __builtin_amdgcn_readfirstlane(tid >> 6), gw = blockIdx.x * NWAVES + wave; (void)lane; (void)gw
    unsigned char* ws = args.ws;
    const float* mod = (const float*)(ws + WS_MOD);
    const int lo = args.ph_lo, hi = args.ph_hi;
#define IN(k) (lo <= (k) && (k) < hi)
#ifndef PROBE_REP
#define PROBE_REP -1
#endif
#define REPS(k) for (int rep_ = 0; rep_ < ((PROBE_REP == (k)) ? 2 : 1); ++rep_, (void)((PROBE_REP == (k) && rep_ < 2) ? (cg::this_grid().sync(), 0) : 0))
#define SEAM(k) do { if (IN(k) && IN((k) + 1)) { xcd_barrier(bar); } } while (0)
    if (lo < 0) cg::this_grid().sync();
    typedef pg8::bf16_t* bp; typedef const pg8::bf16_t* cbp;

    if (IN(0)) REPS(0) { FRESH_IDS(); phase0(args, lds, tid, lane, wave, G, rep_ == 0); }
    SEAM(0);
    if (IN(1)) REPS(1) { FRESH_IDS(); norm_mod_rows(args.in[0], args.in[4], mod, 0, DM, (bf16*)(ws + WS_H), ws + WS_H8, lane, gw, NGW); }
    SEAM(1);
    if (IN(2)) REPS(2) {
        {
            pg8::Gemm g{(cbp)(ws + WS_H), (cbp)(ws + WS_WIN), DM, DM, DM, 0, 1 << 30, 0, 0, (cbp)(ws + WS_WIN) + (size_t)3072 * DM, (cbp)(ws + WS_H)};
            pg8::TwoGemmOrder S; S.init(MTOK, 3072, SBW, MTOK, G, (int)blockIdx.x);
            pg8::EpiP2 E{{(bp)(ws + WS_U), (bp)(ws + WS_Q), (bp)(ws + WS_K), (bp)(ws + WS_SG)}, {(bp)(ws + WS_VT)}};
            pg8::gemm_phase<pg8::EpiP2, pg8::TwoGemmOrder, true, true>(lds, g, S, E);
        }
        {
            pg8::Gemm g{(cbp)(ws + WS_H8), (cbp)(ws + WS_WG8), DM / 2, DM / 2, DM / 2, 0, 1 << 30, 0, 0}; pg8::StaticOrder S; S.init(MTOK, 4096, G, (int)blockIdx.x);
            pg8::EpiGate8 E{(unsigned char*)(ws + WS_SG)};
            pg8::gemm_phase<pg8::EpiGate8, pg8::StaticOrder, true, true, true>(lds, g, S, E);
        }
    }
    SEAM(2);
    if (IN(4)) {
        for (int arep_ = 0; arep_ < (PROBE_REP == 4 ? 2 : 1); ++arep_) { FRESH_IDS();
        for (int u = gw; u < BATCH * NH * 64; u += NGW) attn_unit(u, (const bf16*)(ws + WS_Q), (const bf16*)(ws + WS_K), (const bf16*)(ws + WS_VT), (bf16*)(ws + WS_AM), args.in[6], args.in[7], lane); }
        if ((int)blockIdx.x >= G / 2) { FRESH_IDS(); bias2_gemv(args, lane, ((int)blockIdx.x - G / 2) * NWAVES + wave, (G - G / 2) * NWAVES); }
        {
            FRESH_IDS(); pg8::StaticOrder S; S.init(MTOK, PW, G, (int)blockIdx.x); pg8::Unit u;
            const v2u* U4 = (const v2u*)(ws + WS_U); v2u* P4 = (v2u*)(ws + WS_POOLED);
            for (int i = 0; S.next(i, u); ++i)
                for (int e = 0; e < 2; ++e) { const int idx = tid + NTHREADS * e, m0 = u.pm * 256 + (idx >> 6) * 16, c4 = u.pn * 64 + (idx & 63);
                    if (u.pn == 0) pool_chunk<2>(U4, P4, m0, c4); else if (u.pn == 1) pool_chunk<4>(U4, P4, m0, c4); else if (u.pn == 2) pool_chunk<8>(U4, P4, m0, c4); else pool_chunk<16>(U4, P4, m0, c4); }
            asm volatile("s_waitcnt vmcnt(0)" ::: "memory");
        }
        __syncthreads();
        {
            pg8::Gemm g{(cbp)(ws + WS_POOLED), (cbp)(ws + WS_WPOOL), 256, PW, 256, 256, 1 << 30, 0, 0}; pg8::StaticOrder S; S.init(MTOK, PW, G, (int)blockIdx.x);
            pg8::EpiBf16<2> E{(bp)(ws + WS_AM) + SBW, DM, args.in[9]};
            pg8::gemm_phase<pg8::EpiBf16<2>, pg8::StaticOrder, true, true>(lds, g, S, E);
        }
    }
    SEAM(4);
    if (IN(5)) REPS(5) {
        pg8::Gemm g{(cbp)(ws + WS_AM), (cbp)(ws + WS_WBA), DM, DM, DM, 0, 1 << 30, 0, (SBW / 64)}; pg8::StaticOrder S; S.init(MTOK, DM, G, (int)blockIdx.x);
        pg8::EpiGateMerge E{(const unsigned char*)(ws + WS_SG), (bp)(ws + WS_H)};
        pg8::gemm_phase<pg8::EpiGateMerge, pg8::StaticOrder, true, true>(lds, g, S, E);
    }
    SEAM(5);
    if (IN(6)) REPS(6) {
        pg8::Gemm g{(cbp)(ws + WS_H), (cbp)(ws + WS_WO), DM, DM, DM, 0, 1 << 30, 0, 0}; pg8::StaticOrder S; S.init(MTOK, DM, G, (int)blockIdx.x);
        pg8::EpiResNorm E{args.in[0], (bp)(ws + WS_X1B), mod, args.in[13], (bp)(ws + WS_A2), (float*)(ws + WS_ROWSQ)};
        pg8::gemm_phase<pg8::EpiResNorm, pg8::StaticOrder, true, true>(lds, g, S, E);
    }
    SEAM(6);
    if (IN(8)) REPS(8) {
        pg8::Gemm g{(cbp)(ws + WS_A2), (cbp)(ws + WS_WFF1), DM, DM, DM, 0, 1 << 30, 0, 0}; pg8::StaticOrder S; S.init(MTOK, DFF, G, (int)blockIdx.x);
        pg8::EpiFF1 E{(bp)(ws + WS_F1), (const float*)(ws + WS_ROWSQ), (const float*)(ws + WS_BIAS2)};
        pg8::gemm_phase<pg8::EpiFF1, pg8::StaticOrder, true, true>(lds, g, S, E);
    }
    SEAM(8);
    if (IN(9)) {
        pg8::Gemm g{(cbp)(ws + WS_F1), (cbp)(ws + WS_WFF2), DFF, DFF, DFF, 0, 1 << 30, 0, 0}; pg8::StaticOrder S; S.init(MTOK, DM, G, (int)blockIdx.x);
        pg8::EpiOut E{(cbp)(ws + WS_X1B), args.out, mod + 5 * DM};
        pg8::gemm_phase<pg8::EpiOut, pg8::StaticOrder, true, true>(lds, g, S, E);
    }
#undef IN
#undef SEAM
}

extern "C" void kernel_launch(void* const* d_in, const int* in_sizes, int n_in, void* d_out, int out_size, void* d_ws, size_t ws_size, hipStream_t stream) {
    static int grid = 0;
    if (grid == 0) {
        if (n_in != 16 || out_size != MTOK * DM || ws_size < WS_END) { fprintf(stderr, "kernel_launch: unexpected shapes (n_in %d, out %d, ws %zu)\n", n_in, out_size, ws_size); grid = -1; return; }
        int dev = 0, cus = 0, per_cu = 0;
        if (hipGetDevice(&dev) != hipSuccess || hipDeviceGetAttribute(&cus, hipDeviceAttributeMultiprocessorCount, dev) != hipSuccess) { grid = -1; return; }
        if (hipFuncSetAttribute((const void*)mega_fwd, hipFuncAttributeMaxDynamicSharedMemorySize, LDS_BYTES) != hipSuccess) { fprintf(stderr, "kernel_launch: hipFuncSetAttribute failed\n"); grid = -1; return; }
        if (hipOccupancyMaxActiveBlocksPerMultiprocessor(&per_cu, (const void*)mega_fwd, NTHREADS, LDS_BYTES) != hipSuccess || per_cu < 1) { fprintf(stderr, "kernel_launch: occupancy query says %d\n", per_cu); (void)hipGetLastError(); grid = -1; return; }
        grid = cus;
    }
    if (grid < 0) return;
    (void)hipMemsetAsync((char*)d_ws + WS_MOD, 0, CTL_ZERO_BYTES, stream);
    Args a{};
    for (int i = 0; i < 16; ++i) a.in[i] = (const float*)d_in[i];
    a.out = (float*)d_out; a.ws = (unsigned char*)d_ws;
#if MK_N_LAUNCHES == 1
    a.ph_lo = 0; a.ph_hi = 10;
    void* kargs[] = {&a};
    hipError_t e = hipLaunchCooperativeKernel((const void*)mega_fwd, dim3(grid), dim3(NTHREADS), kargs, LDS_BYTES, stream);
    if (e != hipSuccess) fprintf(stderr, "cooperative launch failed: %s (grid %d)\n", hipGetErrorString(e), grid);
#else
    for (int p = 0; p < 10; ++p) { a.ph_lo = p; a.ph_hi = p + 1; hipLaunchKernelGGL(mega_fwd, dim3(grid), dim3(NTHREADS), LDS_BYTES, stream, a); }
#endif
}
```
